# Optimizing an MI355X kernel written in HIP

```python
import math
import jax, jax.numpy as jnp
from jax import lax
import numpy as np

D_MODEL = 4096
BATCH = 4
SEQ = 2048
DEPTH = 2

N_MIXERS = 2
EXPAND = 2
D_INNER = EXPAND * D_MODEL
D_MEM_BRANCH = D_INNER // 4
D_MIX = D_INNER - D_MEM_BRANCH
MEM_LEN = 256
MEM_HEADS = 4
MEM_HEAD_DIM = D_MEM_BRANCH // MEM_HEADS
POOL_WINDOWS = (2, 4, 8, 16)
POOL_GROUP = D_MIX // len(POOL_WINDOWS)
DIFF_QK_DIM = 128
DIFF_V_DIM = 2 * DIFF_QK_DIM
DIFF_HEADS = D_MIX // DIFF_V_DIM
Q_BLOCK = 128
RMS_EPS = 1e-6
SUBLN_EPS = 1e-5
IN_POOL = D_MIX + D_MEM_BRANCH + D_INNER
IN_DIFF = 3 * D_MIX + D_MEM_BRANCH + D_INNER

kernel_name = "hybrid_pool_diffattn_gated_memory_trunk"


def rmsnorm(x, g, eps=RMS_EPS):
    xf = x.astype(jnp.float32)
    y = xf * lax.rsqrt(jnp.mean(xf * xf, axis=-1, keepdims=True) + eps)
    return (y * g.astype(jnp.float32)).astype(x.dtype)


def alibi_slopes(n):
    def pow2(m):
        start = 2.0 ** (-8.0 / m)
        return [start ** (i + 1) for i in range(m)]
    if math.log2(n).is_integer():
        s = pow2(n)
    else:
        c = 2 ** math.floor(math.log2(n))
        s = pow2(c) + pow2(2 * c)[0::2][: n - c]
    return np.asarray(s, dtype=np.float32)


def lambda_init_fn(layer_idx):
    return 0.8 - 0.6 * math.exp(-0.3 * layer_idx)


def pool_mixer(u, pool_w, pool_scale):
    B, S, _ = u.shape
    uf = u.astype(jnp.float32)
    cs = jnp.cumsum(uf, axis=1)
    t = jnp.arange(S)
    outs = []
    for g, w in enumerate(POOL_WINDOWS):
        sl = slice(g * POOL_GROUP, (g + 1) * POOL_GROUP)
        c = cs[..., sl]
        prev = jnp.pad(c, ((0, 0), (w, 0), (0, 0)))[:, :S]
        cnt = jnp.minimum(t + 1, w).astype(jnp.float32)[None, :, None]
        outs.append((c - prev) / cnt - uf[..., sl])
    pooled = jnp.stack(outs, axis=2).astype(u.dtype)
    mixed = jnp.einsum('bsgc,gcd->bsgd', pooled, pool_w)
    return mixed.reshape(B, S, D_MIX) * pool_scale


def diff_attention(q, k, v, lam, lambda_init, subln_g):
    B, S, H, _, dk = q.shape
    nb = S // Q_BLOCK
    slopes = jnp.asarray(alibi_slopes(H))
    qb = q.reshape(B, nb, Q_BLOCK, H, 2, dk).transpose(1, 0, 2, 3, 4, 5)
    kpos = jnp.arange(S)
    scale = DIFF_QK_DIM ** -0.5

    def block(args):
        qi, i = args
        qpos = i * Q_BLOCK + jnp.arange(Q_BLOCK)
        s = jnp.einsum('bqhjd,bkhjd->bhjqk', qi, k).astype(jnp.float32) * scale
        dist = (qpos[:, None] - kpos[None, :]).astype(jnp.float32)
        s = s - slopes[None, :, None, None, None] * dist
        s = jnp.where(dist >= 0, s, -jnp.inf)
        p = jax.nn.softmax(s, axis=-1)
        a = p[:, :, 0] - lam * p[:, :, 1]
        return jnp.einsum('bhqk,bkhd->bqhd', a.astype(v.dtype), v)

    o = lax.map(block, (qb, jnp.arange(nb)))
    o = o.transpose(1, 0, 2, 3, 4).reshape(B, S, H, DIFF_V_DIM)
    o = rmsnorm(o, subln_g, SUBLN_EPS) * (1.0 - lambda_init)
    return o.reshape(B, S, H * DIFF_V_DIM)


def mem_attention(qm, mem, mem_norm_g, w_mem_kv):
    B, S, _ = qm.shape
    kv = jnp.einsum('bmd,de->bme', rmsnorm(mem, mem_norm_g), w_mem_kv)
    km = kv[..., :D_MEM_BRANCH].reshape(B, -1, MEM_HEADS, MEM_HEAD_DIM)
    vm = kv[..., D_MEM_BRANCH:].reshape(B, -1, MEM_HEADS, MEM_HEAD_DIM)
    qh = qm.reshape(B, S, MEM_HEADS, MEM_HEAD_DIM)
    s = jnp.einsum('bqhd,bkhd->bhqk', qh, km).astype(jnp.float32) * MEM_HEAD_DIM ** -0.5
    p = jax.nn.softmax(s, axis=-1)
    o = jnp.einsum('bhqk,bkhd->bqhd', p.astype(vm.dtype), vm)
    return o.reshape(B, S, D_MEM_BRANCH)


def pool_layer(x, mem, norm_g, w_in, pool_w, pool_scale, mem_norm_g, w_mem_kv, w_out):
    h = rmsnorm(x, norm_g)
    proj = jnp.einsum('bsd,de->bse', h, w_in)
    u = proj[..., :D_MIX]
    qm = proj[..., D_MIX:D_MIX + D_MEM_BRANCH]
    z = proj[..., D_MIX + D_MEM_BRANCH:]
    y = jnp.concatenate([pool_mixer(u, pool_w, pool_scale),
                         mem_attention(qm, mem, mem_norm_g, w_mem_kv)], axis=-1)
    return x + jnp.einsum('bse,ed->bsd', y * jax.nn.silu(z), w_out)


def diff_layer(x, mem, layer_idx, norm_g, w_in, lq1, lk1, lq2, lk2, subln_g,
               mem_norm_g, w_mem_kv, w_out):
    B, S, _ = x.shape
    h = rmsnorm(x, norm_g)
    proj = jnp.einsum('bsd,de->bse', h, w_in)
    q = proj[..., :D_MIX].reshape(B, S, DIFF_HEADS, 2, DIFF_QK_DIM)
    k = proj[..., D_MIX:2 * D_MIX].reshape(B, S, DIFF_HEADS, 2, DIFF_QK_DIM)
    v = proj[..., 2 * D_MIX:3 * D_MIX].reshape(B, S, DIFF_HEADS, DIFF_V_DIM)
    qm = proj[..., 3 * D_MIX:3 * D_MIX + D_MEM_BRANCH]
    z = proj[..., 3 * D_MIX + D_MEM_BRANCH:]
    lam_init = lambda_init_fn(layer_idx)
    f32 = jnp.float32
    lam = (jnp.exp(jnp.sum(lq1.astype(f32) * lk1.astype(f32)))
           - jnp.exp(jnp.sum(lq2.astype(f32) * lk2.astype(f32))) + lam_init)
    y = jnp.concatenate([diff_attention(q, k, v, lam, lam_init, subln_g),
                         mem_attention(qm, mem, mem_norm_g, w_mem_kv)], axis=-1)
    return x + jnp.einsum('bse,ed->bsd', y * jax.nn.silu(z), w_out)


def setup_inputs(seed: int = 0) -> dict:
    key = jax.random.key(seed)
    ks = jax.random.split(key, 24)
    f32 = jnp.float32
    nrm = lambda k, shape, s: jax.random.normal(k, shape, f32) * s
    gain = lambda k, n: 1.0 + 0.02 * jax.random.normal(k, (n,), f32)
    return {
        "x": jax.random.normal(ks[0], (BATCH, SEQ, D_MODEL), f32),
        "mem": jax.random.normal(ks[1], (BATCH, MEM_LEN, D_MODEL), f32),
        "l0_norm_g": gain(ks[2], D_MODEL),
        "l0_w_in": nrm(ks[3], (D_MODEL, IN_POOL), D_MODEL ** -0.5),
        "l0_pool_w": nrm(ks[4], (len(POOL_WINDOWS), POOL_GROUP, POOL_GROUP), POOL_GROUP ** -0.5),
        "l0_pool_scale": gain(ks[5], D_MIX),
        "l0_mem_norm_g": gain(ks[6], D_MODEL),
        "l0_w_mem_kv": nrm(ks[7], (D_MODEL, 2 * D_MEM_BRANCH), D_MODEL ** -0.5),
        "l0_w_out": nrm(ks[8], (D_INNER, D_MODEL), D_INNER ** -0.5),
        "l1_norm_g": gain(ks[9], D_MODEL),
        "l1_w_in": nrm(ks[10], (D_MODEL, IN_DIFF), D_MODEL ** -0.5),
        "l1_lambda_q1": nrm(ks[11], (DIFF_QK_DIM,), 0.1),
        "l1_lambda_k1": nrm(ks[12], (DIFF_QK_DIM,), 0.1),
        "l1_lambda_q2": nrm(ks[13], (DIFF_QK_DIM,), 0.1),
        "l1_lambda_k2": nrm(ks[14], (DIFF_QK_DIM,), 0.1),
        "l1_subln_g": gain(ks[15], DIFF_V_DIM),
        "l1_mem_norm_g": gain(ks[16], D_MODEL),
        "l1_w_mem_kv": nrm(ks[17], (D_MODEL, 2 * D_MEM_BRANCH), D_MODEL ** -0.5),
        "l1_w_out": nrm(ks[18], (D_INNER, D_MODEL), D_INNER ** -0.5),
        "final_norm_g": gain(ks[19], D_MODEL),
    }


def reference(x, mem, l0_norm_g, l0_w_in, l0_pool_w, l0_pool_scale, l0_mem_norm_g,
              l0_w_mem_kv, l0_w_out, l1_norm_g, l1_w_in, l1_lambda_q1, l1_lambda_k1,
              l1_lambda_q2, l1_lambda_k2, l1_subln_g, l1_mem_norm_g, l1_w_mem_kv,
              l1_w_out, final_norm_g):
    pool_params = [(l0_norm_g, l0_w_in, l0_pool_w, l0_pool_scale, l0_mem_norm_g,
                    l0_w_mem_kv, l0_w_out)]
    diff_params = [(l1_norm_g, l1_w_in, l1_lambda_q1, l1_lambda_k1, l1_lambda_q2,
                    l1_lambda_k2, l1_subln_g, l1_mem_norm_g, l1_w_mem_kv, l1_w_out)]
    for i in range(DEPTH):
        if i % N_MIXERS == 0:
            x = pool_layer(x, mem, *pool_params[i // N_MIXERS])
        else:
            x = diff_layer(x, mem, i, *diff_params[i // N_MIXERS])
    return rmsnorm(x, final_norm_g)
```

```cpp
#include <hip/hip_runtime.h>
#include <cstdio>
#include <cstdint>

#ifndef REPEAT_PHASE
#define REPEAT_PHASE -1
#endif
#ifndef EPI_NT
#define EPI_NT 0
#endif
#ifndef PG8_SP2
#define PG8_SP2 1
#endif
#ifndef MK_PER_PHASE
#define MK_PER_PHASE 0
#endif

#define LAS __attribute__((address_space(3)))
#define GAS __attribute__((address_space(1)))
typedef unsigned short bf16_t;
typedef short bf16x8 __attribute__((ext_vector_type(8)));
typedef short s16x4 __attribute__((ext_vector_type(4)));
typedef float f32x4 __attribute__((ext_vector_type(4)));
typedef float f32x2 __attribute__((ext_vector_type(2)));
typedef float f32x16 __attribute__((ext_vector_type(16)));
typedef unsigned u32x4 __attribute__((ext_vector_type(4)));
typedef unsigned u32x2 __attribute__((ext_vector_type(2)));

constexpr int DM = 4096, SEQ = 2048, NB = 4, M = NB * SEQ, DI = 8192, DMEMB = 2048, DMIX = 6144, MEMLEN = 256, MHD = 512, PGRP = 1536, NHEAD = 24;
constexpr int N0 = 16384, N1 = 28672, MROWS = NB * MEMLEN;
constexpr int PADE = 128, LD4 = DM + PADE, LD8 = DI + PADE, LD6 = DMIX + PADE, LD2 = DMEMB + PADE, LDP = PGRP + PADE;
constexpr int NCT6 = DMIX / 256, NCT2 = DMEMB / 256, NCT8 = DI / 256;
__device__ __forceinline__ size_t blk(int row, int col, int nct) { return ((size_t)((row >> 8) * nct + (col >> 8)) << 16) + (size_t)(((row & 255) << 8) + (col & 255)); }
constexpr float RMS_EPS = 1e-6f, SUBLN_EPS = 1e-5f;
constexpr float LOG2E = 1.4426950408889634f;

__device__ __forceinline__ unsigned cvt_pk_bf16(float lo, float hi) { unsigned r; asm volatile("v_cvt_pk_bf16_f32 %0, %1, %2" : "=v"(r) : "v"(lo), "v"(hi)); return r; }
__device__ __forceinline__ float bf_lo(unsigned w) { return __uint_as_float(w << 16); }
__device__ __forceinline__ float bf_hi(unsigned w) { return __uint_as_float(w & 0xffff0000u); }
__device__ __forceinline__ float silu_f(float v) { return v * __builtin_amdgcn_rcpf(1.0f + __builtin_amdgcn_exp2f(-LOG2E * v)); }

namespace pg8 {
constexpr int BM = 256, BK = 64, HALF = 128, HTB = HALF * BK * 2, STAGE_BYTES = 8 * HTB, NXCD = 8, WGM = 8;
__host__ __device__ __forceinline__ int lds_byte(int r, int c) { const int st = (r >> 4) * 2 + (c >> 5), rr = r & 15, cc = c & 31, ob = rr * 64 + cc * 2; return st * 1024 + (ob ^ (((ob >> 9) & 1) << 5)); }
__host__ __device__ __forceinline__ void stage_rc(int b, int& R, int& C) { const int st = b / 1024, sb = b % 1024, swz = sb ^ (((sb >> 9) & 1) << 5); R = (st >> 1) * 16 + swz / 64; C = (st & 1) * 32 + (swz % 64) / 2; }
__host__ __device__ __forceinline__ int perm32(int rho) { const int n = rho >> 4, i = rho & 15; return 8 * (i >> 2) + 4 * n + (i & 3); }

struct Unit { int pm, pn, g; };
struct Gemm { const bf16_t* A; const bf16_t* Bt; int lda, ldb, K; size_t gsA, gsB; int ablk = 0, bblk = 0; };

__device__ __forceinline__ void tile_map(int wgid, int nM, int nN, int& pm, int& pn) {
    const int nwg = nM * nN;
    { const int q = nwg / NXCD, r = nwg % NXCD, xcd = wgid % NXCD, off = wgid / NXCD; wgid = (xcd < r ? xcd * (q + 1) : r * (q + 1) + (xcd - r) * q) + off; }
    const int nig = WGM * nN, gid = wgid / nig, fm = gid * WGM, gsz = (nM - fm) < WGM ? (nM - fm) : WGM;
    pm = fm + ((wgid % nig) % gsz); pn = (wgid % nig) / gsz;
}
struct Sched {
    int nM, nN, per, total, G, c;
    __device__ void init(int nM_, int nN_, int ngroups, int G_, int c_) { nM = nM_; nN = nN_; per = nM_ * nN_; total = per * ngroups; G = G_; c = c_; }
    __device__ __forceinline__ bool next(int i, Unit& u) const {
        const int L = i * G + c; if (L >= total || c >= G) return false;
        u.g = L / per; tile_map(L % per, nM, nN, u.pm, u.pn); return true;
    }
};

__device__ __forceinline__ void store8(bf16_t* p, f32x4 v0, f32x4 v1) {
    u32x4 w; w.x = cvt_pk_bf16(v0[0], v0[1]); w.y = cvt_pk_bf16(v0[2], v0[3]); w.z = cvt_pk_bf16(v1[0], v1[1]); w.w = cvt_pk_bf16(v1[2], v1[3]);
#if EPI_NT
    __builtin_nontemporal_store(w, (u32x4*)p);
#else
    *(u32x4*)p = w;
#endif
}
struct EpiProj {
    static constexpr bool PERM = true;
    bf16_t *b0, *b1, *b2, *b3, *b4; int e0, e1, e2, e3;
    const float* rowss;
    __device__ __forceinline__ void pre(const Unit& u, int wr, int fr, float (&rq)[2][4]) const {
#pragma unroll
        for (int ai = 0; ai < 2; ++ai)
#pragma unroll
            for (int m = 0; m < 4; ++m) rq[ai][m] = rowss ? __hip_atomic_load(rowss + u.pm * BM + wr * 64 + fr + ai * HALF + m * 16, __ATOMIC_RELAXED, __HIP_MEMORY_SCOPE_AGENT) : 0.f;
    }
    __device__ __forceinline__ void operator()(const f32x4 (&acc)[2][2][4][2], const Unit& u, int wr, int wc, int fr, int fq, const float (&rq)[2][4]) const {
        const int pn = u.pn; bf16_t* base; int nct, ct; bool act = false;
        if (pn < e0) { base = b0; nct = NCT6; ct = pn; }
        else if (pn < e1) { base = b1; nct = NCT6; ct = pn - e0; }
        else if (pn < e2) { base = b2; nct = NCT6; ct = pn - e1; }
        else if (pn < e3) { base = b3; nct = NCT2; ct = pn - e2; }
        else { base = b4; nct = NCT8; ct = pn - e3; act = true; }
        bf16_t* tile = base + ((size_t)(u.pm * nct + ct) << 16) + (wr * 64 + fr) * 256 + wc * 32 + 8 * fq;
        float rs[2][4];
#pragma unroll
        for (int ai = 0; ai < 2; ++ai)
#pragma unroll
            for (int m = 0; m < 4; ++m) rs[ai][m] = rowss ? __builtin_amdgcn_rsqf(rq[ai][m] * (1.0f / DM) + RMS_EPS) : 1.0f;
#pragma unroll
        for (int ai = 0; ai < 2; ++ai)
#pragma unroll
            for (int m = 0; m < 4; ++m) { bf16_t* rowp = tile + (ai * HALF + m * 16) * 256;
#pragma unroll
                for (int bj = 0; bj < 2; ++bj) { f32x4 v0 = acc[ai][bj][m][0] * rs[ai][m], v1 = acc[ai][bj][m][1] * rs[ai][m];
                    if (act) {
#pragma unroll
                        for (int j = 0; j < 4; ++j) { v0[j] = silu_f(v0[j]); v1[j] = silu_f(v1[j]); } }
                    store8(rowp + bj * HALF, v0, v1); } }
    }
};
struct EpiKV {
    static constexpr bool PERM = true;
    bf16_t *o0, *o1;
    __device__ __forceinline__ void pre(const Unit&, int, int, float (&)[2][4]) const {}
    __device__ __forceinline__ void operator()(const f32x4 (&acc)[2][2][4][2], const Unit& u, int wr, int wc, int fr, int fq, const float (&)[2][4]) const {
        bf16_t* base = u.g ? o1 : o0; const int row0 = u.pm * BM + wr * 64 + fr, col0 = u.pn * BM + wc * 32 + 8 * fq;
#pragma unroll
        for (int ai = 0; ai < 2; ++ai)
#pragma unroll
            for (int m = 0; m < 4; ++m) { bf16_t* rowp = base + (size_t)(row0 + ai * HALF + m * 16) * LD4 + col0;
#pragma unroll
                for (int bj = 0; bj < 2; ++bj) store8(rowp + bj * HALF, acc[ai][bj][m][0], acc[ai][bj][m][1]); }
    }
};
struct EpiPool {
    static constexpr bool PERM = true;
    const bf16_t* sz; bf16_t* yg; const float* scale;
    __device__ __forceinline__ void pre(const Unit&, int, int, float (&)[2][4]) const {}
    __device__ __forceinline__ void operator()(const f32x4 (&acc)[2][2][4][2], const Unit& u, int wr, int wc, int fr, int fq, const float (&)[2][4]) const {
        const int col0 = u.g * PGRP + u.pn * BM + wc * 32 + 8 * fq;
        const size_t t0 = ((size_t)(u.pm * NCT8 + u.g * (PGRP / 256) + u.pn) << 16) + (wr * 64 + fr) * 256 + wc * 32 + 8 * fq;
        f32x4 sc[2][2];
#pragma unroll
        for (int bj = 0; bj < 2; ++bj) { sc[bj][0] = *(const f32x4*)(scale + col0 + bj * HALF); sc[bj][1] = *(const f32x4*)(scale + col0 + bj * HALF + 4); }
        u32x4 zv[2][4][2];
#pragma unroll
        for (int ai = 0; ai < 2; ++ai)
#pragma unroll
            for (int m = 0; m < 4; ++m)
#pragma unroll
                for (int bj = 0; bj < 2; ++bj) zv[ai][m][bj] = *(const u32x4*)(sz + t0 + (ai * HALF + m * 16) * 256 + bj * HALF);
#pragma unroll
        for (int ai = 0; ai < 2; ++ai) {
#pragma unroll
            for (int m = 0; m < 4; ++m) { bf16_t* rowp = yg + t0 + (ai * HALF + m * 16) * 256;
#pragma unroll
                for (int bj = 0; bj < 2; ++bj) { const u32x4 z = zv[ai][m][bj];
                    f32x4 v0 = acc[ai][bj][m][0] * sc[bj][0], v1 = acc[ai][bj][m][1] * sc[bj][1];
                    v0[0] *= bf_lo(z.x); v0[1] *= bf_hi(z.x); v0[2] *= bf_lo(z.y); v0[3] *= bf_hi(z.y);
                    v1[0] *= bf_lo(z.z); v1[1] *= bf_hi(z.z); v1[2] *= bf_lo(z.w); v1[3] *= bf_hi(z.w);
                    store8(rowp + bj * HALF, v0, v1); } } }
    }
};
template <bool RESBF> struct EpiResid {
    static constexpr bool PERM = true;
    const void* res; bf16_t* outb; float* rowss;
    __device__ __forceinline__ void pre(const Unit&, int, int, float (&)[2][4]) const {}
    __device__ __forceinline__ void operator()(const f32x4 (&acc)[2][2][4][2], const Unit& u, int wr, int wc, int fr, int fq, const float (&)[2][4]) const {
        const int row0 = u.pm * BM + wr * 64 + fr, col0 = u.pn * BM + wc * 32 + 8 * fq;
        u32x4 rw[2][4][2];
        if constexpr (RESBF) {
#pragma unroll
            for (int ai = 0; ai < 2; ++ai)
#pragma unroll
                for (int m = 0; m < 4; ++m)
#pragma unroll
                    for (int bj = 0; bj < 2; ++bj) rw[ai][m][bj] = *(const u32x4*)((const bf16_t*)res + (size_t)(row0 + ai * HALF + m * 16) * LD4 + col0 + bj * HALF);
        }
#pragma unroll
        for (int ai = 0; ai < 2; ++ai) {
            f32x4 rv[4][2][2];
#pragma unroll
            for (int m = 0; m < 4; ++m)
#pragma unroll
                for (int bj = 0; bj < 2; ++bj) { const int row = row0 + ai * HALF + m * 16, col = col0 + bj * HALF;
                    if constexpr (RESBF) { const u32x4 w = rw[ai][m][bj];
                        rv[m][bj][0] = (f32x4){bf_lo(w.x), bf_hi(w.x), bf_lo(w.y), bf_hi(w.y)}; rv[m][bj][1] = (f32x4){bf_lo(w.z), bf_hi(w.z), bf_lo(w.w), bf_hi(w.w)}; }
                    else { const float* rp = (const float*)res + (size_t)row * DM + col; rv[m][bj][0] = *(const f32x4*)rp; rv[m][bj][1] = *(const f32x4*)(rp + 4); } }
#pragma unroll
            for (int m = 0; m < 4; ++m) { const int row = row0 + ai * HALF + m * 16; float ssq = 0.f;
#pragma unroll
                for (int bj = 0; bj < 2; ++bj) { const f32x4 v0 = rv[m][bj][0] + acc[ai][bj][m][0], v1 = rv[m][bj][1] + acc[ai][bj][m][1];
                    ssq += (v0[0] * v0[0] + v0[1] * v0[1]) + (v0[2] * v0[2] + v0[3] * v0[3]) + (v1[0] * v1[0] + v1[1] * v1[1]) + (v1[2] * v1[2] + v1[3] * v1[3]);
                    store8(outb + (size_t)row * LD4 + col0 + bj * HALF, v0, v1); }
                ssq += __shfl_xor(ssq, 16); ssq += __shfl_xor(ssq, 32);
                if (fq == 0) (void)__hip_atomic_fetch_add(rowss + row, ssq, __ATOMIC_RELAXED, __HIP_MEMORY_SCOPE_AGENT); } }
    }
};
template <class Epi>
__device__ __forceinline__ void gemm_phase(LAS unsigned char* lds, const Gemm g, const Sched& S, const Epi& E) {
    const int tid = threadIdx.x, wid = __builtin_amdgcn_readfirstlane(tid >> 6), lane = tid & 63, wr = wid >> 2, wc = wid & 3, fr = lane & 15, fq = lane >> 4;
    const int nt = g.K / BK;
    unsigned voffA[2], voffB[2];
#pragma unroll
    for (int i = 0; i < 2; ++i) { int R, C; stage_rc(tid * 16 + i * 8192, R, C); const int Rb = Epi::PERM ? ((R & ~31) + perm32(R & 31)) : R;
        voffA[i] = (unsigned)(R * g.lda + C) * 2u; voffB[i] = (unsigned)(Rb * g.ldb + C) * 2u; }
    const size_t kstep = (size_t)(BK * 2);
    const size_t hA = (size_t)HALF * g.lda * 2, hB = (size_t)HALF * g.ldb * 2, tA = g.ablk ? ((size_t)(g.K >> 8) << 17) : 2 * hA, tB = g.bblk ? ((size_t)(g.K >> 8) << 17) : 2 * hB;
#define KOA(t_) (g.ablk ? (((size_t)((t_) >> 2) << 17) + (size_t)((t_) & 3) * 128) : (size_t)(t_) * kstep)
#define KOB(t_) (g.bblk ? (((size_t)((t_) >> 2) << 17) + (size_t)((t_) & 3) * 128) : (size_t)(t_) * kstep)
    const unsigned ldsw = (unsigned)wid * 1024u;
    const int aoff = lds_byte(wr * 64 + fr, fq * 8), boff = lds_byte(wc * 32 + fr, fq * 8);
#define PG8_SA(b, h) (((b) * 2 + (h)) * HTB)
#define PG8_SB(b, h) ((4 + (b) * 2 + (h)) * HTB)
#define PG8_STAGE(bufoff, gbase, voff) do { _Pragma("unroll") for (int _i = 0; _i < 2; ++_i) \
        __builtin_amdgcn_global_load_lds((const unsigned*)((const char*)(gbase) + (voff)[_i]), (LAS unsigned*)(lds + (bufoff) + ldsw + _i * 8192), 16, 0, 0); } while (0)
#define PG8_LDA(dst, b, h) do { _Pragma("unroll") for (int m = 0; m < 4; ++m) _Pragma("unroll") for (int k = 0; k < 2; ++k) dst[m][k] = *(const LAS bf16x8*)(lds + PG8_SA(b, h) + aoff + m * 2048 + k * 1024); } while (0)
#define PG8_LDB(dst, b, h) do { _Pragma("unroll") for (int n = 0; n < 2; ++n) _Pragma("unroll") for (int k = 0; k < 2; ++k) dst[n][k] = *(const LAS bf16x8*)(lds + PG8_SB(b, h) + boff + n * 2048 + k * 1024); } while (0)
#define PG8_MMA(ai, bj, At, Bt) do { __builtin_amdgcn_s_setprio(1); _Pragma("unroll") for (int m = 0; m < 4; ++m) _Pragma("unroll") for (int n = 0; n < 2; ++n) _Pragma("unroll") for (int k = 0; k < 2; ++k) \
        acc[ai][bj][m][n] = __builtin_amdgcn_mfma_f32_16x16x32_bf16(Bt[n][k], At[m][k], acc[ai][bj][m][n], 0, 0, 0); __builtin_amdgcn_s_setprio(0); } while (0)
#define PG8_WAIT_V(n) asm volatile("s_waitcnt vmcnt(" #n ")" ::: "memory")
#define PG8_WAIT_L(n) asm volatile("s_waitcnt lgkmcnt(" #n ")" ::: "memory")
#define PG8_BAR __builtin_amdgcn_s_barrier()
#define PG8_SCHED __builtin_amdgcn_sched_barrier(0)
    Unit cur, nxt; int ui = 0;
    if (!S.next(0, cur)) return;
    f32x4 acc[2][2][4][2];
#pragma unroll
    for (int a = 0; a < 2; ++a)
#pragma unroll
        for (int b = 0; b < 2; ++b)
#pragma unroll
            for (int m = 0; m < 4; ++m)
#pragma unroll
                for (int n = 0; n < 2; ++n) acc[a][b][m][n] = (f32x4){0.f, 0.f, 0.f, 0.f};
    float rq[2][4]; E.pre(cur, wr, fr, rq);
    bf16x8 At[4][2], B0[2][2], B1[2][2];
    const char* cA = (const char*)g.A + (size_t)cur.g * g.gsA + (size_t)cur.pm * tA; const char* cB = (const char*)g.Bt + (size_t)cur.g * g.gsB + (size_t)cur.pn * tB;
#if PG8_SP2
    PG8_STAGE(PG8_SB(0, 0), cB, voffB); PG8_STAGE(PG8_SB(0, 1), cB + hB, voffB); PG8_STAGE(PG8_SA(0, 0), cA, voffA); PG8_STAGE(PG8_SA(0, 1), cA + hA, voffA);
    if (wr == 1) PG8_BAR;
    PG8_WAIT_V(2); PG8_BAR;
    PG8_STAGE(PG8_SB(1, 0), cB + KOB(1), voffB); PG8_STAGE(PG8_SA(1, 0), cA + KOA(1), voffA); PG8_STAGE(PG8_SB(1, 1), cB + hB + KOB(1), voffB);
    PG8_WAIT_V(6); PG8_BAR;
#else
    PG8_STAGE(PG8_SB(0, 0), cB, voffB); PG8_STAGE(PG8_SA(0, 0), cA, voffA); PG8_STAGE(PG8_SB(0, 1), cB + hB, voffB); PG8_STAGE(PG8_SA(0, 1), cA + hA, voffA);
    if (wr == 1) PG8_BAR;
    PG8_WAIT_V(4); PG8_BAR;
    PG8_STAGE(PG8_SB(1, 0), cB + KOB(1), voffB); PG8_STAGE(PG8_SA(1, 0), cA + KOA(1), voffA); PG8_STAGE(PG8_SB(1, 1), cB + hB + KOB(1), voffB);
    PG8_WAIT_V(6); PG8_BAR;
#endif
    for (;;) {
        const bool has_next = S.next(ui + 1, nxt);
        const char* nA = has_next ? (const char*)g.A + (size_t)nxt.g * g.gsA + (size_t)nxt.pm * tA : cA; const char* nB = has_next ? (const char*)g.Bt + (size_t)nxt.g * g.gsB + (size_t)nxt.pn * tB : cB;
        for (int t = 0; t < nt; t += 2) {
            const bool last = (t == nt - 2);
            const char* a1 = cA + KOA(t + 1);
            const char* a2 = last ? nA : cA + KOA(t + 2); const char* b2 = last ? nB : cB + KOB(t + 2);
            const char* a3 = last ? nA + KOA(1) : cA + KOA(t + 3); const char* b3 = last ? nB + KOB(1) : cB + KOB(t + 3);
#if PG8_SP2
            PG8_LDB(B0, 0, 0); PG8_LDB(B1, 0, 1); PG8_SCHED; PG8_LDA(At, 0, 0); PG8_STAGE(PG8_SA(1, 1), a1 + hA, voffA);
            PG8_WAIT_V(8); PG8_WAIT_L(0); PG8_BAR; PG8_MMA(0, 0, At, B0); PG8_MMA(0, 1, At, B1); PG8_BAR; PG8_SCHED;
            PG8_LDA(At, 0, 1); PG8_STAGE(PG8_SB(0, 0), b2, voffB); PG8_STAGE(PG8_SB(0, 1), b2 + hB, voffB); PG8_STAGE(PG8_SA(0, 0), a2, voffA);
            PG8_WAIT_V(8); PG8_WAIT_L(0); PG8_BAR; PG8_MMA(1, 0, At, B0); PG8_MMA(1, 1, At, B1); PG8_BAR; PG8_SCHED;
            PG8_LDB(B0, 1, 0); PG8_LDB(B1, 1, 1); PG8_SCHED; PG8_LDA(At, 1, 0); PG8_STAGE(PG8_SA(0, 1), a2 + hA, voffA);
            PG8_WAIT_V(8); PG8_WAIT_L(0); PG8_BAR; PG8_MMA(0, 0, At, B0); PG8_MMA(0, 1, At, B1); PG8_BAR; PG8_SCHED;
            PG8_LDA(At, 1, 1); PG8_STAGE(PG8_SB(1, 0), b3, voffB); PG8_STAGE(PG8_SB(1, 1), b3 + hB, voffB); PG8_STAGE(PG8_SA(1, 0), a3, voffA);
            PG8_WAIT_V(8); PG8_WAIT_L(0); PG8_BAR; PG8_MMA(1, 0, At, B0); PG8_MMA(1, 1, At, B1); PG8_BAR; PG8_SCHED;
        #else
            PG8_LDB(B0, 0, 0); PG8_SCHED; PG8_LDA(At, 0, 0); PG8_STAGE(PG8_SA(1, 1), a1 + hA, voffA);
            PG8_WAIT_L(8); PG8_BAR; PG8_WAIT_L(0); PG8_MMA(0, 0, At, B0); PG8_BAR; PG8_SCHED;
            PG8_LDB(B1, 0, 1); PG8_STAGE(PG8_SB(0, 0), b2, voffB);
            PG8_BAR; PG8_WAIT_L(0); PG8_MMA(0, 1, At, B1); PG8_BAR;
            PG8_LDA(At, 0, 1); PG8_STAGE(PG8_SA(0, 0), a2, voffA);
            PG8_BAR; PG8_WAIT_L(0); PG8_MMA(1, 0, At, B0); PG8_BAR; PG8_SCHED;
            PG8_STAGE(PG8_SB(0, 1), b2 + hB, voffB);
            PG8_WAIT_V(6); PG8_BAR; PG8_MMA(1, 1, At, B1); PG8_BAR;
            PG8_LDB(B0, 1, 0); PG8_SCHED; PG8_LDA(At, 1, 0); PG8_STAGE(PG8_SA(0, 1), a2 + hA, voffA);
            PG8_WAIT_L(8); PG8_BAR; PG8_WAIT_L(0); PG8_MMA(0, 0, At, B0); PG8_BAR; PG8_SCHED;
            PG8_LDB(B1, 1, 1); PG8_STAGE(PG8_SB(1, 0), b3, voffB);
            PG8_BAR; PG8_WAIT_L(0); PG8_MMA(0, 1, At, B1); PG8_BAR;
            PG8_LDA(At, 1, 1); PG8_STAGE(PG8_SA(1, 0), a3, voffA);
            PG8_BAR; PG8_WAIT_L(0); PG8_MMA(1, 0, At, B0); PG8_BAR; PG8_SCHED;
            PG8_STAGE(PG8_SB(1, 1), b3 + hB, voffB);
            PG8_WAIT_V(6); PG8_BAR; PG8_MMA(1, 1, At, B1); PG8_BAR;
#endif
        }
        if (wr == 0) PG8_BAR;
        E(acc, cur, wr, wc, fr, fq, rq);
        if (!has_next) break;
#pragma unroll
        for (int a = 0; a < 2; ++a)
#pragma unroll
            for (int b = 0; b < 2; ++b)
#pragma unroll
                for (int m = 0; m < 4; ++m)
#pragma unroll
                    for (int n = 0; n < 2; ++n) acc[a][b][m][n] = (f32x4){0.f, 0.f, 0.f, 0.f};
        cur = nxt; cA = nA; cB = nB; ++ui;
        E.pre(cur, wr, fr, rq);
        if (wr == 1) PG8_BAR;
    }
    PG8_WAIT_V(0);
    PG8_BAR;
#undef KOA
#undef KOB
#undef PG8_SA
#undef PG8_SB
#undef PG8_STAGE
#undef PG8_LDA
#undef PG8_LDB
#undef PG8_MMA
#undef PG8_WAIT_V
#undef PG8_WAIT_L
#undef PG8_BAR
#undef PG8_SCHED
}
}

namespace att {
#define KSWZ(row, colB) ((row) * 256 + ((colB) ^ (((row) & 15) << 4)))
#define SBAR() __builtin_amdgcn_sched_barrier(0)
__device__ __forceinline__ int crow(int r, int hi) { return (r & 3) + 8 * (r >> 2) + 4 * hi; }
__device__ __forceinline__ unsigned dma_k_off(int i, int ld, int wid, int lane) { const int chunk = (i * 8 + wid) * 64 + lane, row = chunk >> 4, cg = (chunk & 15) ^ (row & 15); return (unsigned)(row * ld + cg * 8) * 2u; }
__device__ __forceinline__ void glds16(const void* sbase, unsigned voff, unsigned lds_dst) {
    unsigned keep;
    asm volatile("s_mov_b32 %0, m0\n\ts_mov_b32 m0, %3\n\ts_nop 0\n\tglobal_load_lds_dwordx4 %1, %2\n\ts_mov_b32 m0, %0" : "=&s"(keep) : "v"(voff), "s"(sbase), "s"(lds_dst) : "memory");
}
__device__ __forceinline__ void glds_tile(const void* k0b, const void* k1b, const void* vb, unsigned k0o, unsigned k1o, unsigned v0, unsigned v1, unsigned v2, unsigned v3, unsigned lds_dst) {
    unsigned keep;
    asm volatile("s_mov_b32 %0, m0\n\t"
                 "s_mov_b32 m0, %10\n\ts_nop 0\n\tglobal_load_lds_dwordx4 %1, %7\n\t"
                 "s_add_u32 m0, m0, 0x2000\n\ts_nop 0\n\tglobal_load_lds_dwordx4 %2, %7\n\t"
                 "s_add_u32 m0, m0, 0x2000\n\ts_nop 0\n\tglobal_load_lds_dwordx4 %1, %8\n\t"
                 "s_add_u32 m0, m0, 0x2000\n\ts_nop 0\n\tglobal_load_lds_dwordx4 %2, %8\n\t"
                 "s_add_u32 m0, m0, 0x2000\n\ts_nop 0\n\tglobal_load_lds_dwordx4 %3, %9\n\t"
                 "s_add_u32 m0, m0, 0x2000\n\ts_nop 0\n\tglobal_load_lds_dwordx4 %4, %9\n\t"
                 "s_add_u32 m0, m0, 0x2000\n\ts_nop 0\n\tglobal_load_lds_dwordx4 %5, %9\n\t"
                 "s_add_u32 m0, m0, 0x2000\n\ts_nop 0\n\tglobal_load_lds_dwordx4 %6, %9\n\t"
                 "s_mov_b32 m0, %0"
                 : "=&s"(keep) : "v"(k0o), "v"(k1o), "v"(v0), "v"(v1), "v"(v2), "v"(v3), "s"(k0b), "s"(k1b), "s"(vb), "s"(lds_dst) : "memory", "scc");
}
__device__ __forceinline__ void dma_k(LAS unsigned char* lds, unsigned dst, const bf16_t* src, unsigned off0, unsigned off1, int wid) {
    const unsigned l0 = (unsigned)(uintptr_t)lds + dst + (unsigned)wid * 1024u;
    glds16(src, off0, l0); glds16(src, off1, l0 + 8192u);
}
__device__ __forceinline__ unsigned dma_v_off(int i, int ld, int wid, int lane) {
    const int o = ((i * 8 + wid) * 64 + lane) * 16, sub = o >> 9, kk = (sub >> 3) * 8 + ((o & 511) >> 6), col = (sub & 7) * 32 + ((o & 63) >> 1);
    const int key = (kk & ~0xC) | ((kk & 4) << 1) | ((kk & 8) >> 1); return (unsigned)(key * ld + col) * 2u;
}
__device__ __forceinline__ void dma_v(LAS unsigned char* lds, unsigned dst, const bf16_t* src, const unsigned (&off)[4], int wid) {
    const unsigned l0 = (unsigned)(uintptr_t)lds + dst + (unsigned)wid * 1024u;
#pragma unroll
    for (int i = 0; i < 4; ++i) glds16(src, off[i], l0 + (unsigned)i * 8192u);
}
__device__ __forceinline__ int v_rd_base(int lane) { return ((lane & 3) << 3) | (((lane >> 2) & 3) << 6) | (((lane >> 4) & 1) << 5) | (((lane >> 5) & 1) << 8); }
constexpr int v_rd_off(int d0, int ks, int half) { return d0 * 512 + ks * 8192 + half * 4096; }
template <int OFF> __device__ __forceinline__ s16x4 tr_read(int vb) {
    s16x4 r; asm volatile("ds_read_b64_tr_b16 %0, %1 offset:%2" : "=&v"(r) : "v"(vb), "i"(OFF) : "memory"); return r;
}
template <int D0> __device__ __forceinline__ void pv_one(f32x16& od, int vb, bf16x8 pa0, bf16x8 pa1, bf16x8 pa2, bf16x8 pa3) {
    const s16x4 l0 = tr_read<v_rd_off(D0, 0, 0)>(vb), h0 = tr_read<v_rd_off(D0, 0, 1)>(vb), l1 = tr_read<v_rd_off(D0, 1, 0)>(vb), h1 = tr_read<v_rd_off(D0, 1, 1)>(vb);
    const s16x4 l2 = tr_read<v_rd_off(D0, 2, 0)>(vb), h2 = tr_read<v_rd_off(D0, 2, 1)>(vb), l3 = tr_read<v_rd_off(D0, 3, 0)>(vb), h3 = tr_read<v_rd_off(D0, 3, 1)>(vb);
    asm volatile("s_waitcnt lgkmcnt(0)" ::: "memory"); SBAR();
#define PK(L, H) (bf16x8){L[0], L[1], L[2], L[3], H[0], H[1], H[2], H[3]}
    od = __builtin_amdgcn_mfma_f32_32x32x16_bf16(pa0, PK(l0, h0), od, 0, 0, 0);
    od = __builtin_amdgcn_mfma_f32_32x32x16_bf16(pa1, PK(l1, h1), od, 0, 0, 0);
    od = __builtin_amdgcn_mfma_f32_32x32x16_bf16(pa2, PK(l2, h2), od, 0, 0, 0);
    od = __builtin_amdgcn_mfma_f32_32x32x16_bf16(pa3, PK(l3, h3), od, 0, 0, 0);
#undef PK
}
__device__ __forceinline__ void pv_all(f32x16 (&o)[8], int vb, bf16x8 pa0, bf16x8 pa1, bf16x8 pa2, bf16x8 pa3) {
    pv_one<0>(o[0], vb, pa0, pa1, pa2, pa3); pv_one<1>(o[1], vb, pa0, pa1, pa2, pa3); pv_one<2>(o[2], vb, pa0, pa1, pa2, pa3); pv_one<3>(o[3], vb, pa0, pa1, pa2, pa3);
    pv_one<4>(o[4], vb, pa0, pa1, pa2, pa3); pv_one<5>(o[5], vb, pa0, pa1, pa2, pa3); pv_one<6>(o[6], vb, pa0, pa1, pa2, pa3); pv_one<7>(o[7], vb, pa0, pa1, pa2, pa3);
}
__device__ __forceinline__ void qkt_acc(f32x16& p0, f32x16& p1, const LAS unsigned char* Ks, const bf16x8 (&qr)[8], int r32, int hi) {
#pragma unroll
    for (int d0 = 0; d0 < 8; ++d0) { const int cb = (d0 * 16 + hi * 8) * 2;
        const bf16x8 b0 = *(const LAS bf16x8*)(Ks + KSWZ(r32, cb));
        const bf16x8 b1 = *(const LAS bf16x8*)(Ks + KSWZ(32 + r32, cb));
        p0 = __builtin_amdgcn_mfma_f32_32x32x16_bf16(b0, qr[d0], p0, 0, 0, 0);
        p1 = __builtin_amdgcn_mfma_f32_32x32x16_bf16(b1, qr[d0], p1, 0, 0, 0); }
}
#define PK4(P, BASE, OUT) do { unsigned a0 = cvt_pk_bf16(P[BASE + 0], P[BASE + 1]), a1 = cvt_pk_bf16(P[BASE + 2], P[BASE + 3]);   \
    unsigned b0 = cvt_pk_bf16(P[BASE + 4], P[BASE + 5]), b1 = cvt_pk_bf16(P[BASE + 6], P[BASE + 7]);                              \
    auto r0 = __builtin_amdgcn_permlane32_swap(a0, b0, false, false); auto r1 = __builtin_amdgcn_permlane32_swap(a1, b1, false, false); \
    u32x4 w = {r0[0], r1[0], r0[1], r1[1]}; OUT = *reinterpret_cast<bf16x8*>(&w); } while (0)
__device__ __forceinline__ float half_max(float v) { auto rr = __builtin_amdgcn_permlane32_swap(__float_as_uint(v), __float_as_uint(v), false, false); return fmaxf(__uint_as_float(rr[0]), __uint_as_float(rr[1])); }
__device__ __forceinline__ float half_sum(float v) { auto rr = __builtin_amdgcn_permlane32_swap(__float_as_uint(v), __float_as_uint(v), false, false); return __uint_as_float(rr[0]) + __uint_as_float(rr[1]); }

struct VFrag { s16x4 l0, h0, l1, h1; };
template <int D0, int HALF> __device__ __forceinline__ void v_issue(VFrag& f, int vb) {
    f.l0 = tr_read<v_rd_off(D0, 2 * HALF, 0)>(vb); f.h0 = tr_read<v_rd_off(D0, 2 * HALF, 1)>(vb); f.l1 = tr_read<v_rd_off(D0, 2 * HALF + 1, 0)>(vb); f.h1 = tr_read<v_rd_off(D0, 2 * HALF + 1, 1)>(vb);
}
#define PKV(L, H) (bf16x8){L[0], L[1], L[2], L[3], H[0], H[1], H[2], H[3]}
template <int D0, int HALF> __device__ __forceinline__ void pv_step(f32x16 (&o)[8], VFrag& cur, VFrag& nxt, int vb, bf16x8 pa0, bf16x8 pa1) {
    if constexpr (D0 < 7) { v_issue<D0 + 1, HALF>(nxt, vb); asm volatile("s_waitcnt lgkmcnt(4)" ::: "memory"); }
    else asm volatile("s_waitcnt lgkmcnt(0)" ::: "memory");
    SBAR();
    o[D0] = __builtin_amdgcn_mfma_f32_32x32x16_bf16(pa0, PKV(cur.l0, cur.h0), o[D0], 0, 0, 0);
    o[D0] = __builtin_amdgcn_mfma_f32_32x32x16_bf16(pa1, PKV(cur.l1, cur.h1), o[D0], 0, 0, 0);
    SBAR();
}
template <int HALF> __device__ __forceinline__ void pv_half(f32x16 (&o)[8], VFrag& f0, int vb, bf16x8 pa0, bf16x8 pa1) {
    VFrag f1;
    pv_step<0, HALF>(o, f0, f1, vb, pa0, pa1); pv_step<1, HALF>(o, f1, f0, vb, pa0, pa1); pv_step<2, HALF>(o, f0, f1, vb, pa0, pa1); pv_step<3, HALF>(o, f1, f0, vb, pa0, pa1);
    pv_step<4, HALF>(o, f0, f1, vb, pa0, pa1); pv_step<5, HALF>(o, f1, f0, vb, pa0, pa1); pv_step<6, HALF>(o, f0, f1, vb, pa0, pa1); pv_step<7, HALF>(o, f1, f0, vb, pa0, pa1);
}
struct DiffArgs { const bf16_t* Q; const bf16_t* K; const bf16_t* V; const bf16_t* SZ; bf16_t* YG; const float* subln_g; float lam, lam_scale; };
__device__ __forceinline__ void diff_tile(f32x16 (&o)[8], const LAS unsigned char* Ks, int vb, const bf16x8 (&qr)[8], LAS float* wsc,
                                          float& m_reg, float& l_reg, float slC, float C, int lim0  , bool diag, int r32, int hi) {
    f32x16 p0 = (f32x16){}, p1 = (f32x16){};
    {
        bf16x8 ka[2], kb[2];
        ka[0] = *(const LAS bf16x8*)(Ks + KSWZ(r32, (hi * 8) * 2)); kb[0] = *(const LAS bf16x8*)(Ks + KSWZ(32 + r32, (hi * 8) * 2));
#pragma unroll
        for (int d0 = 0; d0 < 8; ++d0) {
            if (d0 < 7) { const int cb = ((d0 + 1) * 16 + hi * 8) * 2;
                ka[(d0 + 1) & 1] = *(const LAS bf16x8*)(Ks + KSWZ(r32, cb)); kb[(d0 + 1) & 1] = *(const LAS bf16x8*)(Ks + KSWZ(32 + r32, cb)); }
            SBAR();
            p0 = __builtin_amdgcn_mfma_f32_32x32x16_bf16(ka[d0 & 1], qr[d0], p0, 0, 0, 0);
            p1 = __builtin_amdgcn_mfma_f32_32x32x16_bf16(kb[d0 & 1], qr[d0], p1, 0, 0, 0);
            SBAR(); }
    }
    VFrag vf0; v_issue<0, 0>(vf0, vb);
    if (diag) {
#pragma unroll
        for (int r = 0; r < 16; ++r) { const int kp = (r & 3) + 8 * (r >> 2); if (kp > lim0) p0[r] = -INFINITY; if (kp + 32 > lim0) p1[r] = -INFINITY; } }
    float pmax = p0[0];
#pragma unroll
    for (int r = 1; r < 16; ++r) pmax = fmaxf(pmax, p0[r]);
#pragma unroll
    for (int r = 0; r < 16; ++r) pmax = fmaxf(pmax, p1[r]);
    pmax = half_max(pmax) * C;
    float alpha = 1.f;
    if (!__all(pmax - m_reg <= 6.0f)) { const float mn = fmaxf(m_reg, pmax); alpha = __builtin_amdgcn_exp2f(m_reg - mn); m_reg = mn; }
    const float kb0 = -fmaf(slC, (float)lim0, m_reg), kb1 = fmaf(slC, 32.0f, kb0);
    float ps0 = 0.f, ps1 = 0.f;
#pragma unroll
    for (int r = 0; r < 16; ++r) { const float kpf = (float)((r & 3) + 8 * (r >> 2));
        p0[r] = __builtin_amdgcn_exp2f(fmaf(p0[r], C, fmaf(kpf, slC, kb0))); ps0 += p0[r];
        p1[r] = __builtin_amdgcn_exp2f(fmaf(p1[r], C, fmaf(kpf, slC, kb1))); ps1 += p1[r]; }
    const float ps = half_sum(ps0 + ps1); l_reg = l_reg * alpha + ps;
    bf16x8 pa0, pa1, pa2, pa3; PK4(p0, 0, pa0); PK4(p0, 8, pa1); PK4(p1, 0, pa2); PK4(p1, 8, pa3);
    if (__any(alpha < 1.f)) { if (hi == 0) wsc[r32] = alpha; asm volatile("s_waitcnt lgkmcnt(0)" ::: "memory");
#pragma unroll
        for (int r = 0; r < 16; ++r) { const float a = wsc[crow(r, hi)];
#pragma unroll
            for (int d = 0; d < 8; ++d) o[d][r] *= a; } }
    SBAR();
    pv_half<0>(o, vf0, vb, pa0, pa1);
    VFrag vf1; v_issue<0, 1>(vf1, vb); SBAR();
    pv_half<1>(o, vf1, vb, pa2, pa3);
}
__device__ __forceinline__ void diff_unit(LAS unsigned char* lds, LAS float* wsc_all, const DiffArgs& A, int b, int h, int qb, int rev, int wid, int lane) {
    asm volatile("" : "+v"(lane));
    LAS float* wsc = wsc_all + wid * 64;
    const int r32 = lane & 31, hi = lane >> 5, map = wid >> 2, w4 = wid & 3;
    const int q0 = qb * 128, wrow0 = q0 + 32 * w4;
    const size_t rowb = (size_t)b * SEQ;
    const float slope = (h < 16) ? __builtin_amdgcn_exp2f(-0.5f * (float)(h + 1)) : __builtin_amdgcn_exp2f(-0.25f * (float)(2 * (h - 16) + 1));
    const float C = 0.08838834764831845f * LOG2E, slC = slope * LOG2E;
    const bf16_t* K0 = A.K + (((size_t)(b * 8) * NCT6 + h) << 16); const bf16_t* Vb = A.V + (((size_t)(b * 8) * NCT6 + h) << 16);
#define TOFF(jt_) ((((size_t)((jt_) >> 2) * NCT6) << 16) + (size_t)(((jt_) & 3) * 64 * 256))
    const unsigned ko0 = dma_k_off(0, 256, wid, lane), ko1 = ko0 + 16384u;
    unsigned vo[4]; vo[0] = dma_v_off(0, 256, wid, lane);
#pragma unroll
    for (int i = 1; i < 4; ++i) vo[i] = vo[0] + (unsigned)i * 8192u;
    const int NT = 2 * qb + 2;
    const int vbase = (int)(unsigned)(uintptr_t)(lds) + v_rd_base(lane);
    { const size_t ro = TOFF(rev ? NT - 1 : 0); glds_tile(K0 + ro, K0 + 128 + ro, Vb + ro, ko0, ko1, vo[0], vo[1], vo[2], vo[3], (unsigned)(uintptr_t)lds + (unsigned)wid * 1024u); }
    bf16x8 qr[8];
    { const bf16_t* Qw = A.Q + blk((int)rowb + wrow0 + r32, h * 256 + map * 128 + hi * 8, NCT6);
#pragma unroll
      for (int d0 = 0; d0 < 8; ++d0) qr[d0] = *(const bf16x8*)(Qw + d0 * 16); }
    asm volatile("" :: "v"(qr[0]), "v"(qr[1]), "v"(qr[2]), "v"(qr[3]), "v"(qr[4]), "v"(qr[5]), "v"(qr[6]), "v"(qr[7]));
    float m_reg = -1e30f, l_reg = 0.f; f32x16 o[8];
#pragma unroll
    for (int d = 0; d < 8; ++d) o[d] = (f32x16){};
    for (int st = 0; st < NT; ++st) {
        const int jt = rev ? NT - 1 - st : st; const unsigned buf = (unsigned)(st & 1) * 65536u;
        asm volatile("s_waitcnt vmcnt(0)" ::: "memory"); __builtin_amdgcn_s_barrier(); asm volatile("" ::: "memory");
        if (st + 1 < NT) { const unsigned nb = 65536u - buf; const size_t ro = TOFF(rev ? jt - 1 : jt + 1);
            int ln = lane; asm volatile("" : "+v"(ln));
            const unsigned k0o = dma_k_off(0, 256, wid, ln), k1o = k0o + 16384u; unsigned v2[4]; v2[0] = dma_v_off(0, 256, wid, ln);
#pragma unroll
            for (int i = 1; i < 4; ++i) v2[i] = v2[0] + (unsigned)i * 8192u;
            glds_tile(K0 + ro, K0 + 128 + ro, Vb + ro, k0o, k1o, v2[0], v2[1], v2[2], v2[3], (unsigned)(uintptr_t)lds + nb + (unsigned)wid * 1024u);
        }
        const LAS unsigned char* Ks = lds + buf + (unsigned)map * 16384u; const int vb = vbase + (int)buf + 32768;
        const int lim0 = wrow0 + r32 - 64 * jt - 4 * hi;
        if (64 * jt <= wrow0 + 31)
            diff_tile(o, Ks, vb, qr, wsc, m_reg, l_reg, slC, C, lim0, 64 * jt + 63 > wrow0, r32, hi);
    }
    if (hi == 0) wsc[32 + r32] = l_reg;
    asm volatile("s_waitcnt lgkmcnt(0)" ::: "memory");
    float rli[16];
#pragma unroll
    for (int r = 0; r < 16; r += 4) { const f32x4 l4 = *(const LAS f32x4*)(wsc + 32 + 8 * (r >> 2) + 4 * hi);
#pragma unroll
        for (int e = 0; e < 4; ++e) rli[r + e] = __builtin_amdgcn_rcpf(l4[e]); }
    asm volatile("s_waitcnt lgkmcnt(0)" ::: "memory"); __builtin_amdgcn_s_barrier(); asm volatile("" ::: "memory");
    LAS f32x4* Xo = (LAS f32x4*)lds + (size_t)(w4 * 2 + map) * 1024 + lane;
    const LAS f32x4* Xi = (const LAS f32x4*)lds + (size_t)(w4 * 2 + (map ^ 1)) * 1024 + lane;
    float v[4][16];
    if (map == 0) {
#pragma unroll
        for (int dd = 0; dd < 4; ++dd)
#pragma unroll
            for (int r = 0; r < 16; r += 4) { Xo[(dd * 4 + (r >> 2)) * 64] = (f32x4){o[4 + dd][r] * rli[r], o[4 + dd][r + 1] * rli[r + 1], o[4 + dd][r + 2] * rli[r + 2], o[4 + dd][r + 3] * rli[r + 3]};
#pragma unroll
                for (int e = 0; e < 4; ++e) v[dd][r + e] = o[dd][r + e] * rli[r + e]; }
    } else {
#pragma unroll
        for (int dd = 0; dd < 4; ++dd)
#pragma unroll
            for (int r = 0; r < 16; r += 4) { Xo[(dd * 4 + (r >> 2)) * 64] = (f32x4){o[dd][r] * rli[r], o[dd][r + 1] * rli[r + 1], o[dd][r + 2] * rli[r + 2], o[dd][r + 3] * rli[r + 3]};
#pragma unroll
                for (int e = 0; e < 4; ++e) v[dd][r + e] = o[4 + dd][r + e] * rli[r + e]; }
    }
    asm volatile("s_waitcnt lgkmcnt(0)" ::: "memory"); __builtin_amdgcn_s_barrier(); asm volatile("" ::: "memory");
    const int cbase = h * 256 + map * 128, c8 = (lane & 15) * 8, rq = lane >> 4;
    u32x4 gz[8]; float gsub[4];
#pragma unroll
    for (int i = 0; i < 8; ++i) gz[i] = *(const u32x4*)(A.SZ + blk((int)rowb + wrow0 + 4 * i + rq, cbase + c8, NCT8));
#pragma unroll
    for (int dd = 0; dd < 4; ++dd) gsub[dd] = A.subln_g[map * 128 + dd * 32 + r32];
    float ss[16];
#pragma unroll
    for (int r = 0; r < 16; ++r) ss[r] = 0.f;
#pragma unroll
    for (int dd = 0; dd < 4; ++dd)
#pragma unroll
        for (int r = 0; r < 16; r += 4) { const f32x4 x4 = Xi[(dd * 4 + (r >> 2)) * 64];
#pragma unroll
            for (int e = 0; e < 4; ++e) { const float x = x4[e]; const float y = map ? (x - A.lam * v[dd][r + e]) : (v[dd][r + e] - A.lam * x); v[dd][r + e] = y; ss[r + e] += y * y; } }
#define ROR_ADD(X, N) X += __builtin_bit_cast(float, __builtin_amdgcn_update_dpp(0, __builtin_bit_cast(int, X), 0x120 | (N), 0xf, 0xf, false))
#pragma unroll
    for (int r = 0; r < 16; ++r) { float sq = ss[r];
        ROR_ADD(sq, 8); ROR_ADD(sq, 4); ROR_ADD(sq, 2); ROR_ADD(sq, 1);
        sq += __shfl_xor(sq, 16);
        ss[r] = sq; }
#undef ROR_ADD
    if (r32 == 0) {
#pragma unroll
        for (int r = 0; r < 16; r += 4) *(LAS f32x4*)(wsc + 32 + hi * 16 + r) = (f32x4){ss[r], ss[r + 1], ss[r + 2], ss[r + 3]}; }
    asm volatile("s_waitcnt lgkmcnt(0)" ::: "memory"); __builtin_amdgcn_s_barrier(); asm volatile("" ::: "memory");
    { const LAS float* pw = wsc_all + (wid ^ 4) * 64 + 32 + hi * 16;
#pragma unroll
      for (int r = 0; r < 16; r += 4) { const f32x4 p4 = *(const LAS f32x4*)(pw + r);
#pragma unroll
          for (int e = 0; e < 4; ++e) ss[r + e] = __builtin_amdgcn_rsqf((ss[r + e] + p4[e]) * (1.0f / 256.0f) + SUBLN_EPS) * A.lam_scale; } }
    LAS float* T = (LAS float*)lds + wid * 4096;
    { LAS float* Te = T + (4 * hi) * 128 + r32 + hi * 32; LAS float* To = T + (4 * hi) * 128 + r32 - hi * 32;
#pragma unroll
      for (int dd = 0; dd < 4; ++dd)
#pragma unroll
          for (int r = 0; r < 16; ++r) ((dd & 1) ? To : Te)[((r & 3) + 8 * (r >> 2)) * 128 + dd * 32] = v[dd][r] * ss[r] * gsub[dd]; }
    asm volatile("s_waitcnt lgkmcnt(0)" ::: "memory");
    f32x4 ya[8], yb[8];
#pragma unroll
    for (int i = 0; i < 8; ++i) { const LAS float* sp = T + (4 * i + rq) * 128 + (c8 ^ ((i & 1) * 32)); ya[i] = *(const LAS f32x4*)sp; yb[i] = *(const LAS f32x4*)(sp + 4); }
    asm volatile("s_waitcnt lgkmcnt(0)" ::: "memory"); __builtin_amdgcn_s_barrier(); asm volatile("" ::: "memory");
#pragma unroll
    for (int i = 0; i < 8; ++i) { u32x4 w;
        w.x = cvt_pk_bf16(ya[i].x * bf_lo(gz[i].x), ya[i].y * bf_hi(gz[i].x)); w.y = cvt_pk_bf16(ya[i].z * bf_lo(gz[i].y), ya[i].w * bf_hi(gz[i].y));
        w.z = cvt_pk_bf16(yb[i].x * bf_lo(gz[i].z), yb[i].y * bf_hi(gz[i].z)); w.w = cvt_pk_bf16(yb[i].z * bf_lo(gz[i].w), yb[i].w * bf_hi(gz[i].w));
        *(u32x4*)(A.YG + blk((int)rowb + wrow0 + 4 * i + rq, cbase + c8, NCT8)) = w; }
}

#undef TOFF
struct MemArgs { const bf16_t* QM; const bf16_t* KV; const bf16_t* SZ; bf16_t* YG; };
__device__ __forceinline__ void mem_unit(LAS unsigned char* lds, LAS float* wsc_all, const MemArgs& A, int b, int h, int qb, int half, int wid, int lane) {
    asm volatile("" : "+v"(lane));
    LAS float* wsc = wsc_all + wid * 64;
    const int r32 = lane & 31, hi = lane >> 5;
    const size_t qrow = (size_t)b * SEQ + qb * 256 + wid * 32;
    const bf16_t* Kb = A.KV + (size_t)b * MEMLEN * LD4 + h * MHD; const bf16_t* Vb = A.KV + (size_t)b * MEMLEN * LD4 + DMEMB + h * MHD + half * 256;
    const float C = 0.04419417382415922f * LOG2E;
    f32x16 p[8];
#pragma unroll
    for (int i = 0; i < 8; ++i) p[i] = (f32x16){};
    bf16x8 qr[8];
    asm volatile("" ::: "memory"); __builtin_amdgcn_s_barrier(); asm volatile("" ::: "memory");
    { int ln = lane; asm volatile("" : "+v"(ln)); const unsigned ko0 = dma_k_off(0, LD4, wid, ln), ko1 = dma_k_off(1, LD4, wid, ln);
#pragma unroll
      for (int kt = 0; kt < 4; ++kt) dma_k(lds, (unsigned)kt * 16384u, Kb + (size_t)kt * 64 * LD4, ko0, ko1, wid); }
    const bf16_t* Qw = A.QM + blk((int)qrow + r32, h * MHD + hi * 8, NCT2);
#pragma unroll
    for (int d0 = 0; d0 < 8; ++d0) qr[d0] = *(const bf16x8*)(Qw + d0 * 16);
#pragma unroll
    for (int c = 0; c < 4; ++c) {
        asm volatile("s_waitcnt vmcnt(0)" ::: "memory");
        asm volatile("" : "+v"(qr[0]), "+v"(qr[1]), "+v"(qr[2]), "+v"(qr[3]), "+v"(qr[4]), "+v"(qr[5]), "+v"(qr[6]), "+v"(qr[7]));
        __builtin_amdgcn_s_barrier(); asm volatile("" ::: "memory");
        if (c < 3) { int ln = lane; asm volatile("" : "+v"(ln)); const unsigned ko0 = dma_k_off(0, LD4, wid, ln), ko1 = dma_k_off(1, LD4, wid, ln);
#pragma unroll
            for (int kt = 0; kt < 4; ++kt) dma_k(lds, (unsigned)((c + 1) & 1) * 65536u + (unsigned)kt * 16384u, Kb + (size_t)kt * 64 * LD4 + (c + 1) * 128, ko0, ko1, wid);
        }
        const LAS unsigned char* Kc = lds + (c & 1) * 65536;
#pragma unroll
        for (int d0 = 0; d0 < 8; ++d0) { const int cb = (d0 * 16 + hi * 8) * 2;
#pragma unroll
            for (int kt = 0; kt < 4; ++kt) {
                const bf16x8 b0 = *(const LAS bf16x8*)(Kc + kt * 16384 + KSWZ(r32, cb));
                const bf16x8 b1 = *(const LAS bf16x8*)(Kc + kt * 16384 + KSWZ(32 + r32, cb));
                p[2 * kt] = __builtin_amdgcn_mfma_f32_32x32x16_bf16(b0, qr[d0], p[2 * kt], 0, 0, 0);
                p[2 * kt + 1] = __builtin_amdgcn_mfma_f32_32x32x16_bf16(b1, qr[d0], p[2 * kt + 1], 0, 0, 0); }
            SBAR();
            if (c < 3) qr[d0] = *(const bf16x8*)(A.QM + blk((int)qrow + r32, h * MHD + (c + 1) * 128 + hi * 8, NCT2) + d0 * 16);
            SBAR(); }
    }
    asm volatile("" ::: "memory"); __builtin_amdgcn_s_barrier(); asm volatile("" ::: "memory");
    { int ln = lane; asm volatile("" : "+v"(ln)); unsigned vo[4];
#pragma unroll
      for (int i = 0; i < 4; ++i) vo[i] = dma_v_off(i, LD4, wid, ln);
#pragma unroll
      for (int kt = 0; kt < 4; ++kt) dma_v(lds, (unsigned)kt * 32768u, Vb + (size_t)kt * 64 * LD4, vo, wid); }
    float pmax = p[0][0];
#pragma unroll
    for (int i = 0; i < 8; ++i)
#pragma unroll
        for (int r = 0; r < 16; ++r) pmax = fmaxf(pmax, p[i][r]);
    pmax = half_max(pmax);
    const float mn = pmax * C; float ps = 0.f;
#pragma unroll
    for (int i = 0; i < 8; ++i)
#pragma unroll
        for (int r = 0; r < 16; ++r) { p[i][r] = __builtin_amdgcn_exp2f(fmaf(p[i][r], C, -mn)); ps += p[i][r]; }
    ps = half_sum(ps);
    bf16x8 pa[4][4];
#pragma unroll
    for (int kt = 0; kt < 4; ++kt) { PK4(p[2 * kt], 0, pa[kt][0]); PK4(p[2 * kt], 8, pa[kt][1]); PK4(p[2 * kt + 1], 0, pa[kt][2]); PK4(p[2 * kt + 1], 8, pa[kt][3]); }
    f32x16 o[8];
#pragma unroll
    for (int d = 0; d < 8; ++d) o[d] = (f32x16){};
    const int vbase = (int)(unsigned)(uintptr_t)(lds) + v_rd_base(lane);
    asm volatile("s_waitcnt vmcnt(0)" ::: "memory"); __builtin_amdgcn_s_barrier(); asm volatile("" ::: "memory");
#pragma unroll
    for (int kt = 0; kt < 4; ++kt) pv_all(o, vbase + kt * 32768, pa[kt][0], pa[kt][1], pa[kt][2], pa[kt][3]);
    if (hi == 0) wsc[32 + r32] = ps;
    asm volatile("s_waitcnt lgkmcnt(0)" ::: "memory");
    float rli[16];
#pragma unroll
    for (int r = 0; r < 16; r += 4) { const f32x4 l4 = *(const LAS f32x4*)(wsc + 32 + 8 * (r >> 2) + 4 * hi);
#pragma unroll
        for (int e = 0; e < 4; ++e) rli[r + e] = __builtin_amdgcn_rcpf(l4[e]); }
    asm volatile("" ::: "memory"); __builtin_amdgcn_s_barrier(); asm volatile("" ::: "memory");
    const int c8 = (lane & 15) * 8, rq = lane >> 4;
    LAS float* T = (LAS float*)lds + wid * 4096;
    LAS float* Te = T + (4 * hi) * 128 + r32 + hi * 32; LAS float* To = T + (4 * hi) * 128 + r32 - hi * 32;
#pragma unroll
    for (int dq = 0; dq < 8; dq += 4) {
        const int cbase = DMIX + h * MHD + half * 256 + dq * 32;
        u32x4 gz[8];
#pragma unroll
        for (int i = 0; i < 8; ++i) gz[i] = *(const u32x4*)(A.SZ + blk((int)qrow + 4 * i + rq, cbase + c8, NCT8));
#pragma unroll
        for (int dd = 0; dd < 4; ++dd)
#pragma unroll
            for (int r = 0; r < 16; ++r) ((dd & 1) ? To : Te)[((r & 3) + 8 * (r >> 2)) * 128 + dd * 32] = o[dq + dd][r] * rli[r];
        asm volatile("s_waitcnt lgkmcnt(0)" ::: "memory");
        f32x4 ya[8], yb[8];
#pragma unroll
        for (int i = 0; i < 8; ++i) { const LAS float* sp = T + (4 * i + rq) * 128 + (c8 ^ ((i & 1) * 32)); ya[i] = *(const LAS f32x4*)sp; yb[i] = *(const LAS f32x4*)(sp + 4); }
        asm volatile("s_waitcnt lgkmcnt(0)" ::: "memory");
#pragma unroll
        for (int i = 0; i < 8; ++i) { u32x4 w;
            w.x = cvt_pk_bf16(ya[i].x * bf_lo(gz[i].x), ya[i].y * bf_hi(gz[i].x)); w.y = cvt_pk_bf16(ya[i].z * bf_lo(gz[i].y), ya[i].w * bf_hi(gz[i].y));
            w.z = cvt_pk_bf16(yb[i].x * bf_lo(gz[i].z), yb[i].y * bf_hi(gz[i].z)); w.w = cvt_pk_bf16(yb[i].z * bf_lo(gz[i].w), yb[i].w * bf_hi(gz[i].w));
            *(u32x4*)(A.YG + blk((int)qrow + 4 * i + rq, cbase + c8, NCT8)) = w; }
    }
    asm volatile("s_waitcnt lgkmcnt(0)" ::: "memory"); __builtin_amdgcn_s_barrier(); asm volatile("" ::: "memory");
}
#undef PK4
}

constexpr size_t MiB = 1u << 20;
constexpr size_t ws_up(size_t x) { return (x + MiB - 1) / MiB * MiB; }
constexpr size_t WS_CTL = 0, CTL_ZERO_BYTES = 1 * MiB;
constexpr size_t WS_WIN0T = 2 * MiB, WS_POOLWT = WS_WIN0T + ws_up((size_t)N0 * LD4 * 2), WS_WKV0T = WS_POOLWT + ws_up((size_t)4 * PGRP * LDP * 2), WS_WKV1T = WS_WKV0T + ws_up((size_t)DM * LD4 * 2);
constexpr size_t WS_WOUT0T = WS_WKV1T + ws_up((size_t)DM * LD4 * 2), WS_WOUT1T = WS_WOUT0T + ws_up((size_t)DM * LD8 * 2), WS_WIN1T = WS_WOUT1T + ws_up((size_t)DM * LD8 * 2);
constexpr size_t WS_H = WS_WIN1T + ws_up((size_t)N1 * LD4 * 2), WS_MN0 = WS_H + ws_up((size_t)M * LD4 * 2), WS_MN1 = WS_MN0 + ws_up((size_t)MROWS * LD4 * 2), WS_KV0 = WS_MN1 + ws_up((size_t)MROWS * LD4 * 2), WS_KV1 = WS_KV0 + ws_up((size_t)MROWS * LD4 * 2);
constexpr size_t WS_U = WS_KV1 + ws_up((size_t)MROWS * LD4 * 2), WS_PL = WS_U + ws_up((size_t)M * LD6 * 2), WS_V = WS_PL + ws_up((size_t)M * LD6 * 2), WS_QM = WS_V + ws_up((size_t)M * LD6 * 2);
constexpr size_t WS_SZ = WS_QM + ws_up((size_t)M * LD2 * 2), WS_YG = WS_SZ + ws_up((size_t)M * LD8 * 2), WS_X1 = WS_YG + ws_up((size_t)M * LD8 * 2), WS_X2 = WS_X1 + (size_t)M * DM * 4, WS_END = WS_X2 + (size_t)M * DM * 4;
static_assert(WS_END <= (size_t)1700 * MiB, "d_ws map");
constexpr int CW_BAR = 4096, CW_QUEUE = 16384, CW_ROWSS = 131072;
constexpr int RING_BYTES = 131072, WSC_OFF = RING_BYTES, MISC_OFF = WSC_OFF + 2048, LDS_BYTES = 147456;
constexpr int NWAVES = 8, NPHASE = 10;

#define XB_TMO      128
#define XB_XCNT(j)  (256  + 64 * (j))
#define XB_XSUB(j)  (1280 + 64 * (j))
#define XB_XGEN(j)  (2304 + 64 * (j))
#define XB_TOP      3328
#define XB_TOPGEN   3392
#define XCD_BAR_WORDS 3456
#define XB_SPIN_CAP (1u << 18)
__device__ __forceinline__ unsigned xb_ld(unsigned* p)              { return __hip_atomic_load(p, __ATOMIC_RELAXED, __HIP_MEMORY_SCOPE_AGENT); }
__device__ __forceinline__ unsigned xb_add(unsigned* p, unsigned v) { return __hip_atomic_fetch_add(p, v, __ATOMIC_RELAXED, __HIP_MEMORY_SCOPE_AGENT); }
__device__ __forceinline__ unsigned xb_xcc_id() { return (unsigned)__builtin_amdgcn_s_getreg((3 << 11) | 20) & 0xFu; }
#define XB_SPIN(cond, bar) do { unsigned _sp = 0; while (cond) { __builtin_amdgcn_s_sleep(1); \
    if ((++_sp & 255u) == 0u) { if (xb_ld(&(bar)[XB_TMO])) break; if (_sp > XB_SPIN_CAP) { atomicAdd(&(bar)[XB_TMO], 1u); break; } } } } while (0)
struct XcdBarrier { unsigned* bar; unsigned x; volatile LAS unsigned* st; };
__device__ __forceinline__ XcdBarrier xcd_barrier_post(unsigned* bar, volatile LAS unsigned* st) {
    XcdBarrier b; b.bar = bar; b.x = xb_xcc_id(); b.st = st;
    if (threadIdx.x == 0) (void)xb_add(&bar[XB_XCNT(b.x)], 1u);
    return b;
}
__device__ __forceinline__ void xcd_barrier_complete(unsigned* bar, unsigned x, unsigned& nloc, unsigned& nx) {
    const unsigned G = gridDim.x * gridDim.y * gridDim.z;
    unsigned sum, cnt, mine, sp = 0u;
    for (;;) {
        sum = 0u; cnt = 0u; mine = 0u;
#pragma unroll
        for (unsigned j = 0; j < 16; ++j) { const unsigned c = xb_ld(&bar[XB_XCNT(j)]); sum += c; cnt += (c > 0u) ? 1u : 0u; mine = (j == x) ? c : mine; }
        if (sum == G) break;
        __builtin_amdgcn_s_sleep(1);
        if ((++sp & 255u) == 0u) { if (xb_ld(&bar[XB_TMO])) break; if (sp > XB_SPIN_CAP) { atomicAdd(&bar[XB_TMO], 1u); break; } }
    }
    nloc = mine > 0u ? mine : 1u; nx = cnt > 0u ? cnt : 1u;
}
__device__ __forceinline__ void xcd_barrier(const XcdBarrier& b) {
    asm volatile("s_waitcnt vmcnt(0)" ::: "memory");
    __syncthreads();
    if (threadIdx.x == 0) {
        unsigned* bar = b.bar;
        __builtin_amdgcn_s_waitcnt(0);
        unsigned nloc = b.st[0], nx = b.st[1];
        if (nloc == 0u) { xcd_barrier_complete(bar, b.x, nloc, nx); b.st[0] = nloc; b.st[1] = nx; }
        const unsigned old = xb_add(&bar[XB_XSUB(b.x)], 1u);
        const unsigned gen = old / nloc;
        if (old + 1u == (gen + 1u) * nloc) {
            __builtin_amdgcn_fence(__ATOMIC_RELEASE, "agent");
            asm volatile("s_waitcnt vmcnt(0)" ::: "memory");
            const unsigned og = xb_add(&bar[XB_TOP], 1u);
            const unsigned tg = og / nx;
            if (og + 1u == (tg + 1u) * nx) xb_add(&bar[XB_TOPGEN], 1u);
            else XB_SPIN(xb_ld(&bar[XB_TOPGEN]) == tg, bar);
            __builtin_amdgcn_fence(__ATOMIC_ACQUIRE, "agent");
            xb_add(&bar[XB_XGEN(b.x)], 1u);
            asm volatile("s_waitcnt vmcnt(0)" ::: "memory");
        } else {
            XB_SPIN(xb_ld(&bar[XB_XGEN(b.x)]) == gen, bar);
            __builtin_amdgcn_fence(__ATOMIC_ACQUIRE, "agent");
            asm volatile("s_waitcnt vmcnt(0)" ::: "memory");
        }
    }
    __syncthreads();
}

__device__ __forceinline__ float wave_sum(float v) {
#pragma unroll
    for (int o = 1; o < 64; o <<= 1) v += __shfl_xor(v, o);
    return v;
}
__device__ __forceinline__ unsigned f2bf(float f) { unsigned u = __builtin_bit_cast(unsigned, f); return (u + 0x7fffu + ((u >> 16) & 1u)) >> 16; }
__device__ __forceinline__ unsigned pk2(float lo, float hi) { return cvt_pk_bf16(lo, hi); }
__device__ __forceinline__ void transpose_item(const float* W, int K, int N, bf16_t* WT, int ldt, LAS float* scr, int item, int lane, const float* rowgain = nullptr) {
    const int nblk = N / 32, kb = item / nblk, nb = item % nblk, k0 = 64 * kb, n0 = 32 * nb;
    float wv[32];
#pragma unroll
    for (int i = 0; i < 32; ++i) wv[i] = W[(size_t)(k0 + 2 * i + (lane >> 5)) * N + n0 + (lane & 31)];
    if (rowgain) {
#pragma unroll
        for (int i = 0; i < 32; ++i) wv[i] *= rowgain[k0 + 2 * i + (lane >> 5)]; }
#pragma unroll
    for (int i = 0; i < 32; ++i) scr[(2 * i + (lane >> 5)) * 33 + (lane & 31)] = wv[i];
    asm volatile("s_waitcnt lgkmcnt(0)" ::: "memory");
    const int c = lane & 7;
#pragma unroll
    for (int j = 0; j < 4; ++j) { const int n = (lane >> 3) + 8 * j; const LAS float* s = scr + (8 * c) * 33 + n;
        u32x4 o; o.x = pk2(s[0 * 33], s[1 * 33]); o.y = pk2(s[2 * 33], s[3 * 33]); o.z = pk2(s[4 * 33], s[5 * 33]); o.w = pk2(s[6 * 33], s[7 * 33]);
        *(u32x4*)(WT + (size_t)(n0 + n) * ldt + k0 + 8 * c) = o; }
    asm volatile("s_waitcnt lgkmcnt(0)" ::: "memory");
}
struct TrDesc { const float* W; bf16_t* WT; const float* gain; int N, ldt, k0, n0, nkt; };
__device__ __forceinline__ void tr_set(TrDesc& d, const float* W, int N, bf16_t* WT, int ldt, int item, const float* gain, int nkt = 0) {
    const int nblk = N / 32, kb = item / nblk, nb = item % nblk; d.W = W; d.WT = WT; d.gain = gain; d.N = N; d.ldt = ldt; d.k0 = 64 * kb; d.n0 = 32 * nb; d.nkt = nkt;
}
__device__ __forceinline__ void tr_load(const TrDesc& d, float (&wv)[32], int lane) {
#pragma unroll
    for (int i = 0; i < 32; ++i) wv[i] = d.W[(size_t)(d.k0 + 2 * i + (lane >> 5)) * d.N + d.n0 + (lane & 31)];
}
__device__ __forceinline__ void tr_finish(const TrDesc& d, float (&wv)[32], LAS float* scr, int lane) {
    if (d.gain) {
#pragma unroll
        for (int i = 0; i < 32; ++i) wv[i] *= d.gain[d.k0 + 2 * i + (lane >> 5)]; }
#pragma unroll
    for (int i = 0; i < 32; ++i) scr[(2 * i + (lane >> 5)) * 33 + (lane & 31)] = wv[i];
    asm volatile("s_waitcnt lgkmcnt(0)" ::: "memory");
    const int c = lane & 7;
#pragma unroll
    for (int j = 0; j < 4; ++j) { const int n = (lane >> 3) + 8 * j; const LAS float* sp = scr + (8 * c) * 33 + n;
        u32x4 o; o.x = pk2(sp[0 * 33], sp[1 * 33]); o.y = pk2(sp[2 * 33], sp[3 * 33]); o.z = pk2(sp[4 * 33], sp[5 * 33]); o.w = pk2(sp[6 * 33], sp[7 * 33]);
        const int nn = d.n0 + n, kk = d.k0 + 8 * c;
        bf16_t* dst = d.nkt ? d.WT + (((size_t)(nn >> 8) * d.nkt + (kk >> 8)) << 16) + ((nn & 255) << 8) + (kk & 255) : d.WT + (size_t)nn * d.ldt + kk;
        *(u32x4*)dst = o; }
    asm volatile("s_waitcnt lgkmcnt(0)" ::: "memory");
}
__device__ __forceinline__ void rms_row_bf16(const float* xrow, const float* g0, bf16_t* o0, const float* g1, bf16_t* o1, int lane) {
    const f32x4* xr = (const f32x4*)xrow + lane; f32x4 v[16]; float s = 0.f;
#pragma unroll
    for (int j = 0; j < 16; ++j) { v[j] = xr[64 * j]; s += (v[j].x * v[j].x + v[j].y * v[j].y) + (v[j].z * v[j].z + v[j].w * v[j].w); }
    const float rs = __builtin_amdgcn_rsqf(wave_sum(s) * (1.0f / DM) + RMS_EPS);
#pragma unroll
    for (int j = 0; j < 16; ++j) { const f32x4 gg = ((const f32x4*)g0)[lane + 64 * j]; const f32x4 y = v[j] * rs * gg;
        u32x2 w; w.x = pk2(y.x, y.y); w.y = pk2(y.z, y.w); ((u32x2*)o0)[lane + 64 * j] = w; }
    if (o1) {
#pragma unroll
        for (int j = 0; j < 16; ++j) { const f32x4 gg = ((const f32x4*)g1)[lane + 64 * j]; const f32x4 y = v[j] * rs * gg;
            u32x2 w; w.x = pk2(y.x, y.y); w.y = pk2(y.z, y.w); ((u32x2*)o1)[lane + 64 * j] = w; }
    }
}
__device__ __forceinline__ void rms_row2_bf16(const float* xa, const float* xb, const float* g0, bf16_t* oa, bf16_t* ob, int lane) {
    const f32x4* xra = (const f32x4*)xa + lane; const f32x4* xrb = (const f32x4*)xb + lane; f32x4 va[16], vb[16]; float sa = 0.f, sb = 0.f;
#pragma unroll
    for (int j = 0; j < 16; ++j) va[j] = xra[64 * j];
#pragma unroll
    for (int j = 0; j < 16; ++j) vb[j] = xrb[64 * j];
#pragma unroll
    for (int j = 0; j < 16; ++j) sa += (va[j].x * va[j].x + va[j].y * va[j].y) + (va[j].z * va[j].z + va[j].w * va[j].w);
#pragma unroll
    for (int j = 0; j < 16; ++j) sb += (vb[j].x * vb[j].x + vb[j].y * vb[j].y) + (vb[j].z * vb[j].z + vb[j].w * vb[j].w);
    const float ra = __builtin_amdgcn_rsqf(wave_sum(sa) * (1.0f / DM) + RMS_EPS), rb = __builtin_amdgcn_rsqf(wave_sum(sb) * (1.0f / DM) + RMS_EPS);
#pragma unroll
    for (int j = 0; j < 16; ++j) { const f32x4 gg = ((const f32x4*)g0)[lane + 64 * j]; const f32x4 ya = va[j] * ra * gg, yb = vb[j] * rb * gg;
        u32x2 w; w.x = pk2(ya.x, ya.y); w.y = pk2(ya.z, ya.w); ((u32x2*)oa)[lane + 64 * j] = w;
        u32x2 z; z.x = pk2(yb.x, yb.y); z.y = pk2(yb.z, yb.w); ((u32x2*)ob)[lane + 64 * j] = z; }
}
__device__ __forceinline__ void rms_row_f32(const float* xrow, const float* g, float* orow, int lane) {
    const f32x4* xr = (const f32x4*)xrow + lane; f32x4 v[16]; float s = 0.f;
#pragma unroll
    for (int j = 0; j < 16; ++j) { v[j] = xr[64 * j]; s += (v[j].x * v[j].x + v[j].y * v[j].y) + (v[j].z * v[j].z + v[j].w * v[j].w); }
    const float rs = __builtin_amdgcn_rsqf(wave_sum(s) * (1.0f / DM) + RMS_EPS);
#pragma unroll
    for (int j = 0; j < 16; ++j) { const f32x4 gg = ((const f32x4*)g)[lane + 64 * j]; ((f32x4*)orow)[lane + 64 * j] = v[j] * rs * gg; }
}
__device__ __forceinline__ void final_row(const bf16_t* xrow, const float* rowss, const float* g, float* orow, int lane) {
    const float rs = __builtin_amdgcn_rsqf(__hip_atomic_load(rowss, __ATOMIC_RELAXED, __HIP_MEMORY_SCOPE_AGENT) * (1.0f / DM) + RMS_EPS);
#pragma unroll
    for (int j = 0; j < 8; ++j) { const u32x4 w = ((const u32x4*)xrow)[lane + 64 * j]; const f32x4 g0 = ((const f32x4*)g)[2 * (lane + 64 * j)], g1 = ((const f32x4*)g)[2 * (lane + 64 * j) + 1];
        ((f32x4*)orow)[2 * (lane + 64 * j)] = (f32x4){bf_lo(w.x), bf_hi(w.x), bf_lo(w.y), bf_hi(w.y)} * rs * g0;
        ((f32x4*)orow)[2 * (lane + 64 * j) + 1] = (f32x4){bf_lo(w.z), bf_hi(w.z), bf_lo(w.w), bf_hi(w.w)} * rs * g1; }
}
__device__ __forceinline__ void final_row2(const bf16_t* xa, const bf16_t* xb, const float* ssa, const float* ssb, const float* g, float* oa, float* ob, int lane) {
    u32x4 wa[8], wb[8];
#pragma unroll
    for (int j = 0; j < 8; ++j) wa[j] = ((const u32x4*)xa)[lane + 64 * j];
#pragma unroll
    for (int j = 0; j < 8; ++j) wb[j] = ((const u32x4*)xb)[lane + 64 * j];
    const float ra = __builtin_amdgcn_rsqf(__hip_atomic_load(ssa, __ATOMIC_RELAXED, __HIP_MEMORY_SCOPE_AGENT) * (1.0f / DM) + RMS_EPS);
    const float rb = __builtin_amdgcn_rsqf(__hip_atomic_load(ssb, __ATOMIC_RELAXED, __HIP_MEMORY_SCOPE_AGENT) * (1.0f / DM) + RMS_EPS);
#pragma unroll
    for (int j = 0; j < 8; ++j) { const f32x4 g0 = ((const f32x4*)g)[2 * (lane + 64 * j)], g1 = ((const f32x4*)g)[2 * (lane + 64 * j) + 1];
        ((f32x4*)oa)[2 * (lane + 64 * j)] = (f32x4){bf_lo(wa[j].x), bf_hi(wa[j].x), bf_lo(wa[j].y), bf_hi(wa[j].y)} * ra * g0;
        ((f32x4*)oa)[2 * (lane + 64 * j) + 1] = (f32x4){bf_lo(wa[j].z), bf_hi(wa[j].z), bf_lo(wa[j].w), bf_hi(wa[j].w)} * ra * g1;
        ((f32x4*)ob)[2 * (lane + 64 * j)] = (f32x4){bf_lo(wb[j].x), bf_hi(wb[j].x), bf_lo(wb[j].y), bf_hi(wb[j].y)} * rb * g0;
        ((f32x4*)ob)[2 * (lane + 64 * j) + 1] = (f32x4){bf_lo(wb[j].z), bf_hi(wb[j].z), bf_lo(wb[j].w), bf_hi(wb[j].w)} * rb * g1; }
}
__device__ __forceinline__ void unpack8(const u32x4 w, float (&f)[8]) { f[0] = bf_lo(w.x); f[1] = bf_hi(w.x); f[2] = bf_lo(w.y); f[3] = bf_hi(w.y); f[4] = bf_lo(w.z); f[5] = bf_hi(w.z); f[6] = bf_lo(w.w); f[7] = bf_hi(w.w); }
#define UB(t_) (ub + (((size_t)((t_) >> 8) * NCT6) << 16) + (size_t)(((t_) & 255) << 8))
template <int W> __device__ __forceinline__ void pool_block(const bf16_t* ub, bf16_t* pb, int t0) {
    constexpr int NR = W - 1 + 16;
    u32x4 row[NR];
    if (t0 == 0) {
#pragma unroll
        for (int i = 0; i < NR; ++i) row[i] = (i >= W - 1) ? *(const u32x4*)UB(i - (W - 1)) : (u32x4){0u, 0u, 0u, 0u};
    } else {
#pragma unroll
        for (int i = 0; i < NR; ++i) row[i] = *(const u32x4*)UB(t0 - (W - 1) + i);
    }
    float s[8];
#pragma unroll
    for (int e = 0; e < 8; ++e) s[e] = 0.f;
#pragma unroll
    for (int i = 0; i < W - 1; ++i) { float f[8]; unpack8(row[i], f);
#pragma unroll
        for (int e = 0; e < 8; ++e) s[e] += f[e]; }
#pragma unroll
    for (int k = 0; k < 16; ++k) { const int t = t0 + k;
        float cur[8]; unpack8(row[W - 1 + k], cur);
        const float inv = 1.0f / (float)((t + 1) < W ? (t + 1) : W);
        float ov[8];
#pragma unroll
        for (int e = 0; e < 8; ++e) { s[e] += cur[e]; ov[e] = s[e] * inv - cur[e]; }
        u32x4 o; o.x = pk2(ov[0], ov[1]); o.y = pk2(ov[2], ov[3]); o.z = pk2(ov[4], ov[5]); o.w = pk2(ov[6], ov[7]);
        *(u32x4*)(pb + (size_t)t * LD6) = o;
        float f[8]; unpack8(row[k], f);
#pragma unroll
        for (int e = 0; e < 8; ++e) s[e] -= f[e]; }
}
__device__ __forceinline__ void pool_items(const bf16_t* U, bf16_t* P, int gw, int ngw, int lane) {
    for (int it = gw; it < NB * 128 * 12; it += ngw) {
        const int cg = it % 12, tc = (it / 12) % 128, b = it / (12 * 128), c0 = cg * 512 + lane * 8, t0 = tc * 16;
        const bf16_t* ub = U + (((size_t)(b * 8) * NCT6 + (c0 >> 8)) << 16) + (c0 & 255); bf16_t* pb = P + (size_t)b * SEQ * LD6 + c0;
        switch (cg / 3) { case 0: pool_block<2>(ub, pb, t0); break; case 1: pool_block<4>(ub, pb, t0); break; case 2: pool_block<8>(ub, pb, t0); break; default: pool_block<16>(ub, pb, t0); break; }
    }
}
#undef UB
struct Args { const float* in[20]; float* out; unsigned char* ws; int ph_lo, ph_hi, li, pad; };
__global__ void __launch_bounds__(NWAVES * 64, 2) fwd(Args args) {
    extern __shared__ __attribute__((aligned(16))) unsigned char lds_raw[];
    LAS unsigned char* lds = (LAS unsigned char*)lds_raw;
    const int tid = threadIdx.x, lane = tid & 63, wave = __builtin_amdgcn_readfirstlane(tid >> 6);
    const int G = gridDim.x, bx = blockIdx.x;
    const int vcu = (G % 8 == 0) ? (bx % 8) * (G / 8) + bx / 8 : bx;
    volatile LAS unsigned* MISC = (volatile LAS unsigned*)(lds + MISC_OFF);
    LAS float* wsc = (LAS float*)(lds + WSC_OFF);
    unsigned char* ws = args.ws;
    unsigned* ctl = (unsigned*)(ws + WS_CTL);
    for (int u = tid; u < (LDS_BYTES - MISC_OFF) / 4; u += NWAVES * 64) ((LAS unsigned*)(lds + MISC_OFF))[u] = 0u;
    __syncthreads();
    XcdBarrier bar; bar.bar = ctl + CW_BAR; bar.x = 0; bar.st = nullptr;
    if (!MK_PER_PHASE) bar = xcd_barrier_post(ctl + CW_BAR, MISC + 8);
    const int lo = args.ph_lo, hi_ph = args.ph_hi;
#ifndef PH_MASK
#define PH_MASK 0x3ff
#endif
#define IN(k) (((PH_MASK >> (k)) & 1) && lo <= (k) && (k) < hi_ph)
#define REP(k) for (int rep_ = 0; rep_ < ((REPEAT_PHASE == (k)) ? 2 : 1); ++rep_)
#define SEAM(k) do { if (IN(k) && IN((k) + 1)) xcd_barrier(bar); } while (0)
    const float* x = args.in[0]; const float* mem = args.in[1];
    bf16_t* win0t = (bf16_t*)(ws + WS_WIN0T); bf16_t* poolwt = (bf16_t*)(ws + WS_POOLWT); bf16_t* wkv0t = (bf16_t*)(ws + WS_WKV0T); bf16_t* wout0t = (bf16_t*)(ws + WS_WOUT0T);
    bf16_t* win1t = (bf16_t*)(ws + WS_WIN1T); bf16_t* wkv1t = (bf16_t*)(ws + WS_WKV1T); bf16_t* wout1t = (bf16_t*)(ws + WS_WOUT1T);
    bf16_t* hbuf = (bf16_t*)(ws + WS_H); bf16_t* mn0 = (bf16_t*)(ws + WS_MN0); bf16_t* mn1 = (bf16_t*)(ws + WS_MN1); bf16_t* kv0 = (bf16_t*)(ws + WS_KV0); bf16_t* kv1 = (bf16_t*)(ws + WS_KV1);
    bf16_t* ubuf = (bf16_t*)(ws + WS_U); bf16_t* plbuf = (bf16_t*)(ws + WS_PL); bf16_t* vbuf = (bf16_t*)(ws + WS_V); bf16_t* qmbuf = (bf16_t*)(ws + WS_QM); bf16_t* szbuf = (bf16_t*)(ws + WS_SZ);
    bf16_t* x2b = (bf16_t*)(ws + WS_X1); bf16_t* ygbuf = (bf16_t*)(ws + WS_YG);
    float* rowss1 = (float*)(ws + WS_CTL) + CW_ROWSS; float* rowss2 = rowss1 + M;
    const int gw = vcu * NWAVES + wave, NGW = G * NWAVES;

    if (IN(0)) REP(0) {
        LAS float* scr = (LAS float*)(lds + wave * 16384);
        constexpr int I_IN0 = (DM / 64) * (N0 / 32), I_PW = (PGRP / 64) * (PGRP / 32), I_KV = (DM / 64) * (DM / 32), I_OUT = (DI / 64) * (DM / 32), I_IN1 = (DM / 64) * (N1 / 32);
        for (int it = gw; it < 2 * I_KV; it += NGW) {
            if (it < I_KV) transpose_item(args.in[7], DM, DM, wkv0t, LD4, scr, it, lane); else transpose_item(args.in[17], DM, DM, wkv1t, LD4, scr, it - I_KV, lane); }
        for (int m = gw; m < MROWS; m += NGW) rms_row_bf16(mem + (size_t)m * DM, args.in[6], mn0 + (size_t)m * LD4, args.in[16], mn1 + (size_t)m * LD4, lane);
        if (!MK_PER_PHASE) xcd_barrier(bar);
        const int gh = G / 2;
        if (bx < gh) {
            pg8::Gemm g{mn0, wkv0t, LD4, LD4, DM, (size_t)(WS_MN1 - WS_MN0), (size_t)(WS_WKV1T - WS_WKV0T)}; pg8::Sched S; S.init(MROWS / 256, DM / 256, 2, gh, bx);
            pg8::EpiKV E{kv0, kv1};
            pg8::gemm_phase<pg8::EpiKV>(lds, g, S, E);
        } else {
            const int gw2 = (bx - gh) * NWAVES + wave, ngw2 = (G - gh) * NWAVES;
            for (int m = gw2; m < M; m += 2 * ngw2) {
                if (m + ngw2 < M) rms_row2_bf16(x + (size_t)m * DM, x + (size_t)(m + ngw2) * DM, args.in[2], hbuf + (size_t)m * LD4, hbuf + (size_t)(m + ngw2) * LD4, lane);
                else rms_row_bf16(x + (size_t)m * DM, args.in[2], hbuf + (size_t)m * LD4, nullptr, nullptr, lane); }
        }
        { constexpr int NQ = I_IN0 + 4 * I_PW + 2 * I_OUT + I_IN1, QSH = NQ / 8, QCH = 2; static_assert(NQ % 8 == 0 && QSH % QCH == 0, "queue shards");
          unsigned* qhead = ctl + CW_QUEUE;
#define Q_PULL(sh_) ({ unsigned v_ = 0u; if (lane == 0) v_ = __hip_atomic_fetch_add(qhead + 64 * (sh_), (unsigned)QCH, __ATOMIC_RELAXED, __HIP_MEMORY_SCOPE_AGENT); v_; })
#define TR_DECODE(d_, it_) do { int r = (it_);                                                                                                  \
            if (r < I_IN0) { tr_set(d_, args.in[3], N0, win0t, LD4, r, nullptr, DM / 256); break; } r -= I_IN0;                                                    \
            if (r < 4 * I_PW) { const int g = r / I_PW; tr_set(d_, args.in[4] + (size_t)g * PGRP * PGRP, PGRP, poolwt + (size_t)g * PGRP * LDP, LDP, r % I_PW, nullptr); break; } r -= 4 * I_PW; \
            if (r < I_OUT) { tr_set(d_, args.in[8], DM, wout0t, LD8, r, nullptr, DI / 256); break; } r -= I_OUT;                                                   \
            if (r < I_IN1) { tr_set(d_, args.in[10], N1, win1t, LD4, r, args.in[9], DM / 256); break; } r -= I_IN1;                                                \
            tr_set(d_, args.in[18], DM, wout1t, LD8, r, nullptr, DI / 256); } while (0)
          int shard = bx & 7, tried = 0; unsigned nxt_v = Q_PULL(shard);
          for (;;) {
              const unsigned cur = (unsigned)__builtin_amdgcn_readfirstlane((int)nxt_v);
              if (cur >= (unsigned)QSH) { if (++tried == 8) break; shard = (shard + 1) & 7; nxt_v = Q_PULL(shard); continue; }
              TrDesc d, e; float wv[32], wu[32]; const int base = shard * QSH + (int)cur;
              TR_DECODE(d, base); tr_load(d, wv, lane); TR_DECODE(e, base + 1); tr_load(e, wu, lane);
              nxt_v = Q_PULL(shard);
              tr_finish(d, wv, scr, lane); tr_finish(e, wu, scr, lane);
          }
#undef TR_DECODE
#undef Q_PULL
        }
    }
    SEAM(0);
    if (IN(1)) REP(1) {
        pg8::Gemm g{hbuf, win0t, LD4, 256, DM, 0, 0, 0, 1}; pg8::Sched S; S.init(M / 256, N0 / 256, 1, G, bx);
        pg8::EpiProj E{ubuf, ubuf, ubuf, qmbuf, szbuf, 24, 24, 24, 32, nullptr};
        pg8::gemm_phase<pg8::EpiProj>(lds, g, S, E);
    }
    SEAM(1);
    if (IN(2)) REP(2) { pool_items(ubuf, plbuf, gw, NGW, lane); }
    SEAM(2);
    if (IN(3)) REP(3) {
        { pg8::Gemm g{plbuf, poolwt, LD6, LDP, PGRP, (size_t)PGRP * 2, (size_t)PGRP * LDP * 2}; pg8::Sched S; S.init(M / 256, PGRP / 256, 4, G, bx);
          pg8::EpiPool E{szbuf, ygbuf, args.in[5]};
          pg8::gemm_phase<pg8::EpiPool>(lds, g, S, E); }
        { const att::MemArgs MA{qmbuf, kv0, szbuf, ygbuf};
          for (int u = bx; u < 256; u += G) att::mem_unit(lds, wsc, MA, u >> 6, (u >> 4) & 3, (u >> 1) & 7, u & 1, wave, lane); }
    }
    SEAM(3);
    if (IN(4)) REP(4) {
        pg8::Gemm g{ygbuf, wout0t, 256, 256, DI, 0, 0, 1, 1}; pg8::Sched S; S.init(M / 256, DM / 256, 1, G, bx);
        pg8::EpiResid<false> E{x, hbuf, rowss1};
        pg8::gemm_phase<pg8::EpiResid<false>>(lds, g, S, E);
    }
    SEAM(4);
    if (IN(6)) REP(6) {
        pg8::Gemm g{hbuf, win1t, LD4, 256, DM, 0, 0, 0, 1}; pg8::Sched S; S.init(M / 256, N1 / 256, 1, G, bx);
        pg8::EpiProj E{ubuf, plbuf, vbuf, qmbuf, szbuf, 24, 48, 72, 80, rowss1};
        pg8::gemm_phase<pg8::EpiProj>(lds, g, S, E);
    }
    SEAM(6);
    if (IN(7)) REP(7) {
        float d1 = args.in[11][lane] * args.in[12][lane] + args.in[11][lane + 64] * args.in[12][lane + 64];
        float d2 = args.in[13][lane] * args.in[14][lane] + args.in[13][lane + 64] * args.in[14][lane + 64];
        d1 = wave_sum(d1); d2 = wave_sum(d2);
        const float lam_init = 0.8f - 0.6f * 0.7408182206817179f;
        const float lam = __expf(d1) - __expf(d2) + lam_init;
        const att::DiffArgs DA{ubuf, plbuf, vbuf, szbuf, ygbuf, args.in[15], lam, 1.0f - lam_init};
        if (wave >= 4) __builtin_amdgcn_s_setprio(1);
        for (int it = bx; it < 768; it += G) {
            const int c = it & 255, rr = it >> 8, x = c & 7, j = c >> 3, k1 = rr * 4 + (j >> 4) * 2, qbi = j & 15;
            const int bh1 = x * 12 + k1, bh2 = bh1 + 1;
            att::diff_unit(lds, wsc, DA, bh1 / NHEAD, bh1 % NHEAD, qbi, 0, wave, lane);
            att::diff_unit(lds, wsc, DA, bh2 / NHEAD, bh2 % NHEAD, 15 - qbi, 1, wave, lane);
        }
        const att::MemArgs MA{qmbuf, kv1, szbuf, ygbuf};
        for (int u = bx; u < 256; u += G) att::mem_unit(lds, wsc, MA, u >> 6, (u >> 4) & 3, (u >> 1) & 7, u & 1, wave, lane);
    }
    __builtin_amdgcn_s_setprio(0);
    SEAM(7);
    if (IN(8)) REP(8) {
        pg8::Gemm g{ygbuf, wout1t, 256, 256, DI, 0, 0, 1, 1}; pg8::Sched S; S.init(M / 256, DM / 256, 1, G, bx);
        pg8::EpiResid<true> E{hbuf, x2b, rowss2};
        pg8::gemm_phase<pg8::EpiResid<true>>(lds, g, S, E);
    }
    SEAM(8);
    if (IN(9)) REP(9) {
        for (int m = gw; m < M; m += 2 * NGW) {
            if (m + NGW < M) final_row2(x2b + (size_t)m * LD4, x2b + (size_t)(m + NGW) * LD4, rowss2 + m, rowss2 + m + NGW, args.in[19], args.out + (size_t)m * DM, args.out + (size_t)(m + NGW) * DM, lane);
            else final_row(x2b + (size_t)m * LD4, rowss2 + m, args.in[19], args.out + (size_t)m * DM, lane);
        }
    }
#undef IN
#undef SEAM
}

extern "C" void kernel_launch(void* const* d_in, const int* in_sizes, int n_in, void* d_out, int out_size, void* d_ws, size_t ws_size, hipStream_t stream) {
    static int grid = 0;
    if (grid == 0) {
        if (n_in != 20 || out_size != M * DM || ws_size < WS_END) { fprintf(stderr, "kernel_launch: unexpected shapes (n_in %d out %d ws %zu)\n", n_in, out_size, ws_size); grid = -1; return; }
        int dev = 0, cus = 0, per_cu = 0;
        if (hipGetDevice(&dev) != hipSuccess || hipDeviceGetAttribute(&cus, hipDeviceAttributeMultiprocessorCount, dev) != hipSuccess) { grid = -1; return; }
        if (hipFuncSetAttribute((const void*)fwd, hipFuncAttributeMaxDynamicSharedMemorySize, LDS_BYTES) != hipSuccess) { fprintf(stderr, "kernel_launch: hipFuncSetAttribute failed\n"); grid = -1; return; }
        if (hipOccupancyMaxActiveBlocksPerMultiprocessor(&per_cu, (const void*)fwd, NWAVES * 64, LDS_BYTES) != hipSuccess || per_cu < 1)
            fprintf(stderr, "kernel_launch: occupancy query reports %d blocks per CU\n", per_cu);
        (void)hipGetLastError();
        grid = cus;
    }
    if (grid < 0) return;
    (void)hipMemsetAsync((char*)d_ws + WS_CTL, 0, CTL_ZERO_BYTES, stream);
    Args a{};
    for (int i = 0; i < 20; ++i) a.in[i] = (const float*)d_in[i];
    a.out = (float*)d_out; a.ws = (unsigned char*)d_ws; a.pad = 0;
#if MK_PER_PHASE
    for (int p = 0; p < NPHASE; ++p) { a.ph_lo = p; a.ph_hi = p + 1; a.li = p; hipLaunchKernelGGL(fwd, dim3(grid), dim3(NWAVES * 64), LDS_BYTES, stream, a); }
#else
    a.ph_lo = 0; a.ph_hi = NPHASE; a.li = 0;
    hipLaunchKernelGGL(fwd, dim3(grid), dim3(NWAVES * 64), LDS_BYTES, stream, a);
#endif
    const hipError_t le = hipPeekAtLastError();
    if (le != hipSuccess) fprintf(stderr, "kernel_launch: launch failed: %s\n", hipGetErrorName(le));
}
```

```cpp
#include <hip/hip_runtime.h>
#include <cstdio>
#include <cstdint>

#ifndef REPEAT_PHASE
#define REPEAT_PHASE -1
#endif
#ifndef EPI_NT
#define EPI_NT 0
#endif
#ifndef PG8_SP2
#define PG8_SP2 1
#endif
#ifndef MK_PER_PHASE
#define MK_PER_PHASE 0
#endif

#define LAS __attribute__((address_space(3)))
#define GAS __attribute__((address_space(1)))
typedef unsigned short bf16_t;
typedef short bf16x8 __attribute__((ext_vector_type(8)));
typedef short s16x4 __attribute__((ext_vector_type(4)));
typedef float f32x4 __attribute__((ext_vector_type(4)));
typedef float f32x2 __attribute__((ext_vector_type(2)));
typedef float f32x16 __attribute__((ext_vector_type(16)));
typedef unsigned u32x4 __attribute__((ext_vector_type(4)));
typedef unsigned u32x2 __attribute__((ext_vector_type(2)));

constexpr int DM = 4096, SEQ = 2048, NB = 4, M = NB * SEQ, DI = 8192, DMEMB = 2048, DMIX = 6144, MEMLEN = 256, MHD = 512, PGRP = 1536, NHEAD = 24;
constexpr int N0 = 16384, N1 = 28672, MROWS = NB * MEMLEN;
constexpr int PADE = 128, LD4 = DM + PADE, LD8 = DI + PADE, LD6 = DMIX + PADE, LD2 = DMEMB + PADE, LDP = PGRP + PADE;
constexpr int NCT6 = DMIX / 256, NCT2 = DMEMB / 256, NCT8 = DI / 256;
__device__ __forceinline__ size_t blk(int row, int col, int nct) { return ((size_t)((row >> 8) * nct + (col >> 8)) << 16) + (size_t)(((row & 255) << 8) + (col & 255)); }
constexpr float RMS_EPS = 1e-6f, SUBLN_EPS = 1e-5f;
constexpr float LOG2E = 1.4426950408889634f;

__device__ __forceinline__ unsigned cvt_pk_bf16(float lo, float hi) { unsigned r; asm volatile("v_cvt_pk_bf16_f32 %0, %1, %2" : "=v"(r) : "v"(lo), "v"(hi)); return r; }
__device__ __forceinline__ float bf_lo(unsigned w) { return __uint_as_float(w << 16); }
__device__ __forceinline__ float bf_hi(unsigned w) { return __uint_as_float(w & 0xffff0000u); }
__device__ __forceinline__ float silu_f(float v) { return v * __builtin_amdgcn_rcpf(1.0f + __builtin_amdgcn_exp2f(-LOG2E * v)); }

namespace pg8 {
constexpr int BM = 256, BK = 64, HALF = 128, HTB = HALF * BK * 2, STAGE_BYTES = 8 * HTB, NXCD = 8, WGM = 8;
__host__ __device__ __forceinline__ int lds_byte(int r, int c) { const int st = (r >> 4) * 2 + (c >> 5), rr = r & 15, cc = c & 31, ob = rr * 64 + cc * 2; return st * 1024 + (ob ^ (((ob >> 9) & 1) << 5)); }
__host__ __device__ __forceinline__ void stage_rc(int b, int& R, int& C) { const int st = b / 1024, sb = b % 1024, swz = sb ^ (((sb >> 9) & 1) << 5); R = (st >> 1) * 16 + swz / 64; C = (st & 1) * 32 + (swz % 64) / 2; }
__host__ __device__ __forceinline__ int perm32(int rho) { const int n = rho >> 4, i = rho & 15; return 8 * (i >> 2) + 4 * n + (i & 3); }

struct Unit { int pm, pn, g; };
struct Gemm { const bf16_t* A; const bf16_t* Bt; int lda, ldb, K; size_t gsA, gsB; int ablk = 0, bblk = 0; };

__device__ __forceinline__ void tile_map(int wgid, int nM, int nN, int& pm, int& pn) {
    const int nwg = nM * nN;
    { const int q = nwg / NXCD, r = nwg % NXCD, xcd = wgid % NXCD, off = wgid / NXCD; wgid = (xcd < r ? xcd * (q + 1) : r * (q + 1) + (xcd - r) * q) + off; }
    const int nig = WGM * nN, gid = wgid / nig, fm = gid * WGM, gsz = (nM - fm) < WGM ? (nM - fm) : WGM;
    pm = fm + ((wgid % nig) % gsz); pn = (wgid % nig) / gsz;
}
struct Sched {
    int nM, nN, per, total, G, c;
    __device__ void init(int nM_, int nN_, int ngroups, int G_, int c_) { nM = nM_; nN = nN_; per = nM_ * nN_; total = per * ngroups; G = G_; c = c_; }
    __device__ __forceinline__ bool next(int i, Unit& u) const {
        const int L = i * G + c; if (L >= total || c >= G) return false;
        u.g = L / per; tile_map(L % per, nM, nN, u.pm, u.pn); return true;
    }
};

__device__ __forceinline__ void store8(bf16_t* p, f32x4 v0, f32x4 v1) {
    u32x4 w; w.x = cvt_pk_bf16(v0[0], v0[1]); w.y = cvt_pk_bf16(v0[2], v0[3]); w.z = cvt_pk_bf16(v1[0], v1[1]); w.w = cvt_pk_bf16(v1[2], v1[3]);
#if EPI_NT
    __builtin_nontemporal_store(w, (u32x4*)p);
#else
    *(u32x4*)p = w;
#endif
}
struct EpiProj {
    static constexpr bool PERM = true;
    bf16_t *b0, *b1, *b2, *b3, *b4; int e0, e1, e2, e3;
    const float* rowss;
    __device__ __forceinline__ void pre(const Unit& u, int wr, int fr, float (&rq)[2][4]) const {
#pragma unroll
        for (int ai = 0; ai < 2; ++ai)
#pragma unroll
            for (int m = 0; m < 4; ++m) rq[ai][m] = rowss ? __hip_atomic_load(rowss + u.pm * BM + wr * 64 + fr + ai * HALF + m * 16, __ATOMIC_RELAXED, __HIP_MEMORY_SCOPE_AGENT) : 0.f;
    }
    __device__ __forceinline__ void operator()(const f32x4 (&acc)[2][2][4][2], const Unit& u, int wr, int wc, int fr, int fq, const float (&rq)[2][4]) const {
        const int pn = u.pn; bf16_t* base; int nct, ct; bool act = false;
        if (pn < e0) { base = b0; nct = NCT6; ct = pn; }
        else if (pn < e1) { base = b1; nct = NCT6; ct = pn - e0; }
        else if (pn < e2) { base = b2; nct = NCT6; ct = pn - e1; }
        else if (pn < e3) { base = b3; nct = NCT2; ct = pn - e2; }
        else { base = b4; nct = NCT8; ct = pn - e3; act = true; }
        bf16_t* tile = base + ((size_t)(u.pm * nct + ct) << 16) + (wr * 64 + fr) * 256 + wc * 32 + 8 * fq;
        float rs[2][4];
#pragma unroll
        for (int ai = 0; ai < 2; ++ai)
#pragma unroll
            for (int m = 0; m < 4; ++m) rs[ai][m] = rowss ? __builtin_amdgcn_rsqf(rq[ai][m] * (1.0f / DM) + RMS_EPS) : 1.0f;
#pragma unroll
        for (int ai = 0; ai < 2; ++ai)
#pragma unroll
            for (int m = 0; m < 4; ++m) { bf16_t* rowp = tile + (ai * HALF + m * 16) * 256;
#pragma unroll
                for (int bj = 0; bj < 2; ++bj) { f32x4 v0 = acc[ai][bj][m][0] * rs[ai][m], v1 = acc[ai][bj][m][1] * rs[ai][m];
                    if (act) {
#pragma unroll
                        for (int j = 0; j < 4; ++j) { v0[j] = silu_f(v0[j]); v1[j] = silu_f(v1[j]); } }
                    store8(rowp + bj * HALF, v0, v1); } }
    }
};
struct EpiKV {
    static constexpr bool PERM = true;
    bf16_t *o0, *o1;
    __device__ __forceinline__ void pre(const Unit&, int, int, float (&)[2][4]) const {}
    __device__ __forceinline__ void operator()(const f32x4 (&acc)[2][2][4][2], const Unit& u, int wr, int wc, int fr, int fq, const float (&)[2][4]) const {
        bf16_t* base = u.g ? o1 : o0; const int row0 = u.pm * BM + wr * 64 + fr, col0 = u.pn * BM + wc * 32 + 8 * fq;
#pragma unroll
        for (int ai = 0; ai < 2; ++ai)
#pragma unroll
            for (int m = 0; m < 4; ++m) { bf16_t* rowp = base + (size_t)(row0 + ai * HALF + m * 16) * LD4 + col0;
#pragma unroll
                for (int bj = 0; bj < 2; ++bj) store8(rowp + bj * HALF, acc[ai][bj][m][0], acc[ai][bj][m][1]); }
    }
};
struct EpiPool {
    static constexpr bool PERM = true;
    const bf16_t* sz; bf16_t* yg; const float* scale;
    __device__ __forceinline__ void pre(const Unit&, int, int, float (&)[2][4]) const {}
    __device__ __forceinline__ void operator()(const f32x4 (&acc)[2][2][4][2], const Unit& u, int wr, int wc, int fr, int fq, const float (&)[2][4]) const {
        const int col0 = u.g * PGRP + u.pn * BM + wc * 32 + 8 * fq;
        const size_t t0 = ((size_t)(u.pm * NCT8 + u.g * (PGRP / 256) + u.pn) << 16) + (wr * 64 + fr) * 256 + wc * 32 + 8 * fq;
        f32x4 sc[2][2];
#pragma unroll
        for (int bj = 0; bj < 2; ++bj) { sc[bj][0] = *(const f32x4*)(scale + col0 + bj * HALF); sc[bj][1] = *(const f32x4*)(scale + col0 + bj * HALF + 4); }
        u32x4 zv[2][4][2];
#pragma unroll
        for (int ai = 0; ai < 2; ++ai)
#pragma unroll
            for (int m = 0; m < 4; ++m)
#pragma unroll
                for (int bj = 0; bj < 2; ++bj) zv[ai][m][bj] = *(const u32x4*)(sz + t0 + (ai * HALF + m * 16) * 256 + bj * HALF);
#pragma unroll
        for (int ai = 0; ai < 2; ++ai) {
#pragma unroll
            for (int m = 0; m < 4; ++m) { bf16_t* rowp = yg + t0 + (ai * HALF + m * 16) * 256;
#pragma unroll
                for (int bj = 0; bj < 2; ++bj) { const u32x4 z = zv[ai][m][bj];
                    f32x4 v0 = acc[ai][bj][m][0] * sc[bj][0], v1 = acc[ai][bj][m][1] * sc[bj][1];
                    v0[0] *= bf_lo(z.x); v0[1] *= bf_hi(z.x); v0[2] *= bf_lo(z.y); v0[3] *= bf_hi(z.y);
                    v1[0] *= bf_lo(z.z); v1[1] *= bf_hi(z.z); v1[2] *= bf_lo(z.w); v1[3] *= bf_hi(z.w);
                    store8(rowp + bj * HALF, v0, v1); } } }
    }
};
template <bool RESBF> struct EpiResid {
    static constexpr bool PERM = true;
    const void* res; bf16_t* outb; float* rowss;
    __device__ __forceinline__ void pre(const Unit&, int, int, float (&)[2][4]) const {}
    __device__ __forceinline__ void operator()(const f32x4 (&acc)[2][2][4][2], const Unit& u, int wr, int wc, int fr, int fq, const float (&)[2][4]) const {
        const int row0 = u.pm * BM + wr * 64 + fr, col0 = u.pn * BM + wc * 32 + 8 * fq;
        u32x4 rw[2][4][2];
        if constexpr (RESBF) {
#pragma unroll
            for (int ai = 0; ai < 2; ++ai)
#pragma unroll
                for (int m = 0; m < 4; ++m)
#pragma unroll
                    for (int bj = 0; bj < 2; ++bj) rw[ai][m][bj] = *(const u32x4*)((const bf16_t*)res + (size_t)(row0 + ai * HALF + m * 16) * LD4 + col0 + bj * HALF);
        }
#pragma unroll
        for (int ai = 0; ai < 2; ++ai) {
            f32x4 rv[4][2][2];
#pragma unroll
            for (int m = 0; m < 4; ++m)
#pragma unroll
                for (int bj = 0; bj < 2; ++bj) { const int row = row0 + ai * HALF + m * 16, col = col0 + bj * HALF;
                    if constexpr (RESBF) { const u32x4 w = rw[ai][m][bj];
                        rv[m][bj][0] = (f32x4){bf_lo(w.x), bf_hi(w.x), bf_lo(w.y), bf_hi(w.y)}; rv[m][bj][1] = (f32x4){bf_lo(w.z), bf_hi(w.z), bf_lo(w.w), bf_hi(w.w)}; }
                    else { const float* rp = (const float*)res + (size_t)row * DM + col; rv[m][bj][0] = *(const f32x4*)rp; rv[m][bj][1] = *(const f32x4*)(rp + 4); } }
#pragma unroll
            for (int m = 0; m < 4; ++m) { const int row = row0 + ai * HALF + m * 16; float ssq = 0.f;
#pragma unroll
                for (int bj = 0; bj < 2; ++bj) { const f32x4 v0 = rv[m][bj][0] + acc[ai][bj][m][0], v1 = rv[m][bj][1] + acc[ai][bj][m][1];
                    ssq += (v0[0] * v0[0] + v0[1] * v0[1]) + (v0[2] * v0[2] + v0[3] * v0[3]) + (v1[0] * v1[0] + v1[1] * v1[1]) + (v1[2] * v1[2] + v1[3] * v1[3]);
                    store8(outb + (size_t)row * LD4 + col0 + bj * HALF, v0, v1); }
                ssq += __shfl_xor(ssq, 16); ssq += __shfl_xor(ssq, 32);
                if (fq == 0) (void)__hip_atomic_fetch_add(rowss + row, ssq, __ATOMIC_RELAXED, __HIP_MEMORY_SCOPE_AGENT); } }
    }
};
template <class Epi>
__device__ __forceinline__ void gemm_phase(LAS unsigned char* lds, const Gemm g, const Sched& S, const Epi& E) {
    const int tid = threadIdx.x, wid = __builtin_amdgcn_readfirstlane(tid >> 6), lane = tid & 63, wr = wid >> 2, wc = wid & 3, fr = lane & 15, fq = lane >> 4;
    const int nt = g.K / BK;
    unsigned voffA[2], voffB[2];
#pragma unroll
    for (int i = 0; i < 2; ++i) { int R, C; stage_rc(tid * 16 + i * 8192, R, C); const int Rb = Epi::PERM ? ((R & ~31) + perm32(R & 31)) : R;
        voffA[i] = (unsigned)(R * g.lda + C) * 2u; voffB[i] = (unsigned)(Rb * g.ldb + C) * 2u; }
    const size_t kstep = (size_t)(BK * 2);
    const size_t hA = (size_t)HALF * g.lda * 2, hB = (size_t)HALF * g.ldb * 2, tA = g.ablk ? ((size_t)(g.K >> 8) << 17) : 2 * hA, tB = g.bblk ? ((size_t)(g.K >> 8) << 17) : 2 * hB;
#define KOA(t_) (g.ablk ? (((size_t)((t_) >> 2) << 17) + (size_t)((t_) & 3) * 128) : (size_t)(t_) * kstep)
#define KOB(t_) (g.bblk ? (((size_t)((t_) >> 2) << 17) + (size_t)((t_) & 3) * 128) : (size_t)(t_) * kstep)
    const unsigned ldsw = (unsigned)wid * 1024u;
    const int aoff = lds_byte(wr * 64 + fr, fq * 8), boff = lds_byte(wc * 32 + fr, fq * 8);
#define PG8_SA(b, h) (((b) * 2 + (h)) * HTB)
#define PG8_SB(b, h) ((4 + (b) * 2 + (h)) * HTB)
#define PG8_STAGE(bufoff, gbase, voff) do { _Pragma("unroll") for (int _i = 0; _i < 2; ++_i) \
        __builtin_amdgcn_global_load_lds((const unsigned*)((const char*)(gbase) + (voff)[_i]), (LAS unsigned*)(lds + (bufoff) + ldsw + _i * 8192), 16, 0, 0); } while (0)
#define PG8_LDA(dst, b, h) do { _Pragma("unroll") for (int m = 0; m < 4; ++m) _Pragma("unroll") for (int k = 0; k < 2; ++k) dst[m][k] = *(const LAS bf16x8*)(lds + PG8_SA(b, h) + aoff + m * 2048 + k * 1024); } while (0)
#define PG8_LDB(dst, b, h) do { _Pragma("unroll") for (int n = 0; n < 2; ++n) _Pragma("unroll") for (int k = 0; k < 2; ++k) dst[n][k] = *(const LAS bf16x8*)(lds + PG8_SB(b, h) + boff + n * 2048 + k * 1024); } while (0)
#define PG8_MMA(ai, bj, At, Bt) do { __builtin_amdgcn_s_setprio(1); _Pragma("unroll") for (int m = 0; m < 4; ++m) _Pragma("unroll") for (int n = 0; n < 2; ++n) _Pragma("unroll") for (int k = 0; k < 2; ++k) \
        acc[ai][bj][m][n] = __builtin_amdgcn_mfma_f32_16x16x32_bf16(Bt[n][k], At[m][k], acc[ai][bj][m][n], 0, 0, 0); __builtin_amdgcn_s_setprio(0); } while (0)
#define PG8_WAIT_V(n) asm volatile("s_waitcnt vmcnt(" #n ")" ::: "memory")
#define PG8_WAIT_L(n) asm volatile("s_waitcnt lgkmcnt(" #n ")" ::: "memory")
#define PG8_BAR __builtin_amdgcn_s_barrier()
#define PG8_SCHED __builtin_amdgcn_sched_barrier(0)
    Unit cur, nxt; int ui = 0;
    if (!S.next(0, cur)) return;
    f32x4 acc[2][2][4][2];
#pragma unroll
    for (int a = 0; a < 2; ++a)
#pragma unroll
        for (int b = 0; b < 2; ++b)
#pragma unroll
            for (int m = 0; m < 4; ++m)
#pragma unroll
                for (int n = 0; n < 2; ++n) acc[a][b][m][n] = (f32x4){0.f, 0.f, 0.f, 0.f};
    float rq[2][4]; E.pre(cur, wr, fr, rq);
    bf16x8 At[4][2], B0[2][2], B1[2][2];
    const char* cA = (const char*)g.A + (size_t)cur.g * g.gsA + (size_t)cur.pm * tA; const char* cB = (const char*)g.Bt + (size_t)cur.g * g.gsB + (size_t)cur.pn * tB;
#if PG8_SP2
    PG8_STAGE(PG8_SB(0, 0), cB, voffB); PG8_STAGE(PG8_SB(0, 1), cB + hB, voffB); PG8_STAGE(PG8_SA(0, 0), cA, voffA); PG8_STAGE(PG8_SA(0, 1), cA + hA, voffA);
    if (wr == 1) PG8_BAR;
    PG8_WAIT_V(2); PG8_BAR;
    PG8_STAGE(PG8_SB(1, 0), cB + KOB(1), voffB); PG8_STAGE(PG8_SA(1, 0), cA + KOA(1), voffA); PG8_STAGE(PG8_SB(1, 1), cB + hB + KOB(1), voffB);
    PG8_WAIT_V(6); PG8_BAR;
#else
    PG8_STAGE(PG8_SB(0, 0), cB, voffB); PG8_STAGE(PG8_SA(0, 0), cA, voffA); PG8_STAGE(PG8_SB(0, 1), cB + hB, voffB); PG8_STAGE(PG8_SA(0, 1), cA + hA, voffA);
    if (wr == 1) PG8_BAR;
    PG8_WAIT_V(4); PG8_BAR;
    PG8_STAGE(PG8_SB(1, 0), cB + KOB(1), voffB); PG8_STAGE(PG8_SA(1, 0), cA + KOA(1), voffA); PG8_STAGE(PG8_SB(1, 1), cB + hB + KOB(1), voffB);
    PG8_WAIT_V(6); PG8_BAR;
#endif
    for (;;) {
        const bool has_next = S.next(ui + 1, nxt);
        const char* nA = has_next ? (const char*)g.A + (size_t)nxt.g * g.gsA + (size_t)nxt.pm * tA : cA; const char* nB = has_next ? (const char*)g.Bt + (size_t)nxt.g * g.gsB + (size_t)nxt.pn * tB : cB;
        for (int t = 0; t < nt; t += 2) {
            const bool last = (t == nt - 2);
            const char* a1 = cA + KOA(t + 1);
            const char* a2 = last ? nA : cA + KOA(t + 2); const char* b2 = last ? nB : cB + KOB(t + 2);
            const char* a3 = last ? nA + KOA(1) : cA + KOA(t + 3); const char* b3 = last ? nB + KOB(1) : cB + KOB(t + 3);
#if PG8_SP2
            PG8_LDB(B0, 0, 0); PG8_LDB(B1, 0, 1); PG8_SCHED; PG8_LDA(At, 0, 0); PG8_STAGE(PG8_SA(1, 1), a1 + hA, voffA);
            PG8_WAIT_V(8); PG8_WAIT_L(0); PG8_BAR; PG8_MMA(0, 0, At, B0); PG8_MMA(0, 1, At, B1); PG8_BAR; PG8_SCHED;
            PG8_LDA(At, 0, 1); PG8_STAGE(PG8_SB(0, 0), b2, voffB); PG8_STAGE(PG8_SB(0, 1), b2 + hB, voffB); PG8_STAGE(PG8_SA(0, 0), a2, voffA);
            PG8_WAIT_V(8); PG8_WAIT_L(0); PG8_BAR; PG8_MMA(1, 0, At, B0); PG8_MMA(1, 1, At, B1); PG8_BAR; PG8_SCHED;
            PG8_LDB(B0, 1, 0); PG8_LDB(B1, 1, 1); PG8_SCHED; PG8_LDA(At, 1, 0); PG8_STAGE(PG8_SA(0, 1), a2 + hA, voffA);
            PG8_WAIT_V(8); PG8_WAIT_L(0); PG8_BAR; PG8_MMA(0, 0, At, B0); PG8_MMA(0, 1, At, B1); PG8_BAR; PG8_SCHED;
            PG8_LDA(At, 1, 1); PG8_STAGE(PG8_SB(1, 0), b3, voffB); PG8_STAGE(PG8_SB(1, 1), b3 + hB, voffB); PG8_STAGE(PG8_SA(1, 0), a3, voffA);
            PG8_WAIT_V(8); PG8_WAIT_L(0); PG8_BAR; PG8_MMA(1, 0, At, B0); PG8_MMA(1, 1, At, B1); PG8_BAR; PG8_SCHED;
        #else
            PG8_LDB(B0, 0, 0); PG8_SCHED; PG8_LDA(At, 0, 0); PG8_STAGE(PG8_SA(1, 1), a1 + hA, voffA);
            PG8_WAIT_L(8); PG8_BAR; PG8_WAIT_L(0); PG8_MMA(0, 0, At, B0); PG8_BAR; PG8_SCHED;
            PG8_LDB(B1, 0, 1); PG8_STAGE(PG8_SB(0, 0), b2, voffB);
            PG8_BAR; PG8_WAIT_L(0); PG8_MMA(0, 1, At, B1); PG8_BAR;
            PG8_LDA(At, 0, 1); PG8_STAGE(PG8_SA(0, 0), a2, voffA);
            PG8_BAR; PG8_WAIT_L(0); PG8_MMA(1, 0, At, B0); PG8_BAR; PG8_SCHED;
            PG8_STAGE(PG8_SB(0, 1), b2 + hB, voffB);
            PG8_WAIT_V(6); PG8_BAR; PG8_MMA(1, 1, At, B1); PG8_BAR;
            PG8_LDB(B0, 1, 0); PG8_SCHED; PG8_LDA(At, 1, 0); PG8_STAGE(PG8_SA(0, 1), a2 + hA, voffA);
            PG8_WAIT_L(8); PG8_BAR; PG8_WAIT_L(0); PG8_MMA(0, 0, At, B0); PG8_BAR; PG8_SCHED;
            PG8_LDB(B1, 1, 1); PG8_STAGE(PG8_SB(1, 0), b3, voffB);
            PG8_BAR; PG8_WAIT_L(0); PG8_MMA(0, 1, At, B1); PG8_BAR;
            PG8_LDA(At, 1, 1); PG8_STAGE(PG8_SA(1, 0), a3, voffA);
            PG8_BAR; PG8_WAIT_L(0); PG8_MMA(1, 0, At, B0); PG8_BAR; PG8_SCHED;
            PG8_STAGE(PG8_SB(1, 1), b3 + hB, voffB);
            PG8_WAIT_V(6); PG8_BAR; PG8_MMA(1, 1, At, B1); PG8_BAR;
#endif
        }
        if (wr == 0) PG8_BAR;
        E(acc, cur, wr, wc, fr, fq, rq);
        if (!has_next) break;
#pragma unroll
        for (int a = 0; a < 2; ++a)
#pragma unroll
            for (int b = 0; b < 2; ++b)
#pragma unroll
                for (int m = 0; m < 4; ++m)
#pragma unroll
                    for (int n = 0; n < 2; ++n) acc[a][b][m][n] = (f32x4){0.f, 0.f, 0.f, 0.f};
        cur = nxt; cA = nA; cB = nB; ++ui;
        E.pre(cur, wr, fr, rq);
        if (wr == 1) PG8_BAR;
    }
    PG8_WAIT_V(0);
    PG8_BAR;
#undef KOA
#undef KOB
#undef PG8_SA
#undef PG8_SB
#undef PG8_STAGE
#undef PG8_LDA
#undef PG8_LDB
#undef PG8_MMA
#undef PG8_WAIT_V
#undef PG8_WAIT_L
#undef PG8_BAR
#undef PG8_SCHED
}
}

namespace att {
#define KSWZ(row, colB) ((row) * 256 + ((colB) ^ (((row) & 15) << 4)))
#define SBAR() __builtin_amdgcn_sched_barrier(0)
__device__ __forceinline__ int crow(int r, int hi) { return (r & 3) + 8 * (r >> 2) + 4 * hi; }
__device__ __forceinline__ unsigned dma_k_off(int i, int ld, int wid, int lane) { const int chunk = (i * 8 + wid) * 64 + lane, row = chunk >> 4, cg = (chunk & 15) ^ (row & 15); return (unsigned)(row * ld + cg * 8) * 2u; }
__device__ __forceinline__ void glds16(const void* sbase, unsigned voff, unsigned lds_dst) {
    unsigned keep;
    asm volatile("s_mov_b32 %0, m0\n\ts_mov_b32 m0, %3\n\ts_nop 0\n\tglobal_load_lds_dwordx4 %1, %2\n\ts_mov_b32 m0, %0" : "=&s"(keep) : "v"(voff), "s"(sbase), "s"(lds_dst) : "memory");
}
__device__ __forceinline__ void glds_tile(const void* k0b, const void* k1b, const void* vb, unsigned k0o, unsigned k1o, unsigned v0, unsigned v1, unsigned v2, unsigned v3, unsigned lds_dst) {
    unsigned keep;
    asm volatile("s_mov_b32 %0, m0\n\t"
                 "s_mov_b32 m0, %10\n\ts_nop 0\n\tglobal_load_lds_dwordx4 %1, %7\n\t"
                 "s_add_u32 m0, m0, 0x2000\n\ts_nop 0\n\tglobal_load_lds_dwordx4 %2, %7\n\t"
                 "s_add_u32 m0, m0, 0x2000\n\ts_nop 0\n\tglobal_load_lds_dwordx4 %1, %8\n\t"
                 "s_add_u32 m0, m0, 0x2000\n\ts_nop 0\n\tglobal_load_lds_dwordx4 %2, %8\n\t"
                 "s_add_u32 m0, m0, 0x2000\n\ts_nop 0\n\tglobal_load_lds_dwordx4 %3, %9\n\t"
                 "s_add_u32 m0, m0, 0x2000\n\ts_nop 0\n\tglobal_load_lds_dwordx4 %4, %9\n\t"
                 "s_add_u32 m0, m0, 0x2000\n\ts_nop 0\n\tglobal_load_lds_dwordx4 %5, %9\n\t"
                 "s_add_u32 m0, m0, 0x2000\n\ts_nop 0\n\tglobal_load_lds_dwordx4 %6, %9\n\t"
                 "s_mov_b32 m0, %0"
                 : "=&s"(keep) : "v"(k0o), "v"(k1o), "v"(v0), "v"(v1), "v"(v2), "v"(v3), "s"(k0b), "s"(k1b), "s"(vb), "s"(lds_dst) : "memory", "scc");
}
__device__ __forceinline__ void dma_k(LAS unsigned char* lds, unsigned dst, const bf16_t* src, unsigned off0, unsigned off1, int wid) {
    const unsigned l0 = (unsigned)(uintptr_t)lds + dst + (unsigned)wid * 1024u;
    glds16(src, off0, l0); glds16(src, off1, l0 + 8192u);
}
__device__ __forceinline__ unsigned dma_v_off(int i, int ld, int wid, int lane) {
    const int o = ((i * 8 + wid) * 64 + lane) * 16, sub = o >> 9, kk = (sub >> 3) * 8 + ((o & 511) >> 6), col = (sub & 7) * 32 + ((o & 63) >> 1);
    const int key = (kk & ~0xC) | ((kk & 4) << 1) | ((kk & 8) >> 1); return (unsigned)(key * ld + col) * 2u;
}
__device__ __forceinline__ void dma_v(LAS unsigned char* lds, unsigned dst, const bf16_t* src, const unsigned (&off)[4], int wid) {
    const unsigned l0 = (unsigned)(uintptr_t)lds + dst + (unsigned)wid * 1024u;
#pragma unroll
    for (int i = 0; i < 4; ++i) glds16(src, off[i], l0 + (unsigned)i * 8192u);
}
__device__ __forceinline__ int v_rd_base(int lane) { return ((lane & 3) << 3) | (((lane >> 2) & 3) << 6) | (((lane >> 4) & 1) << 5) | (((lane >> 5) & 1) << 8); }
constexpr int v_rd_off(int d0, int ks, int half) { return d0 * 512 + ks * 8192 + half * 4096; }
template <int OFF> __device__ __forceinline__ s16x4 tr_read(int vb) {
    s16x4 r; asm volatile("ds_read_b64_tr_b16 %0, %1 offset:%2" : "=&v"(r) : "v"(vb), "i"(OFF) : "memory"); return r;
}
template <int D0> __device__ __forceinline__ void pv_one(f32x16& od, int vb, bf16x8 pa0, bf16x8 pa1, bf16x8 pa2, bf16x8 pa3) {
    const s16x4 l0 = tr_read<v_rd_off(D0, 0, 0)>(vb), h0 = tr_read<v_rd_off(D0, 0, 1)>(vb), l1 = tr_read<v_rd_off(D0, 1, 0)>(vb), h1 = tr_read<v_rd_off(D0, 1, 1)>(vb);
    const s16x4 l2 = tr_read<v_rd_off(D0, 2, 0)>(vb), h2 = tr_read<v_rd_off(D0, 2, 1)>(vb), l3 = tr_read<v_rd_off(D0, 3, 0)>(vb), h3 = tr_read<v_rd_off(D0, 3, 1)>(vb);
    asm volatile("s_waitcnt lgkmcnt(0)" ::: "memory"); SBAR();
#define PK(L, H) (bf16x8){L[0], L[1], L[2], L[3], H[0], H[1], H[2], H[3]}
    od = __builtin_amdgcn_mfma_f32_32x32x16_bf16(pa0, PK(l0, h0), od, 0, 0, 0);
    od = __builtin_amdgcn_mfma_f32_32x32x16_bf16(pa1, PK(l1, h1), od, 0, 0, 0);
    od = __builtin_amdgcn_mfma_f32_32x32x16_bf16(pa2, PK(l2, h2), od, 0, 0, 0);
    od = __builtin_amdgcn_mfma_f32_32x32x16_bf16(pa3, PK(l3, h3), od, 0, 0, 0);
#undef PK
}
__device__ __forceinline__ void pv_all(f32x16 (&o)[8], int vb, bf16x8 pa0, bf16x8 pa1, bf16x8 pa2, bf16x8 pa3) {
    pv_one<0>(o[0], vb, pa0, pa1, pa2, pa3); pv_one<1>(o[1], vb, pa0, pa1, pa2, pa3); pv_one<2>(o[2], vb, pa0, pa1, pa2, pa3); pv_one<3>(o[3], vb, pa0, pa1, pa2, pa3);
    pv_one<4>(o[4], vb, pa0, pa1, pa2, pa3); pv_one<5>(o[5], vb, pa0, pa1, pa2, pa3); pv_one<6>(o[6], vb, pa0, pa1, pa2, pa3); pv_one<7>(o[7], vb, pa0, pa1, pa2, pa3);
}
__device__ __forceinline__ void qkt_acc(f32x16& p0, f32x16& p1, const LAS unsigned char* Ks, const bf16x8 (&qr)[8], int r32, int hi) {
#pragma unroll
    for (int d0 = 0; d0 < 8; ++d0) { const int cb = (d0 * 16 + hi * 8) * 2;
        const bf16x8 b0 = *(const LAS bf16x8*)(Ks + KSWZ(r32, cb));
        const bf16x8 b1 = *(const LAS bf16x8*)(Ks + KSWZ(32 + r32, cb));
        p0 = __builtin_amdgcn_mfma_f32_32x32x16_bf16(b0, qr[d0], p0, 0, 0, 0);
        p1 = __builtin_amdgcn_mfma_f32_32x32x16_bf16(b1, qr[d0], p1, 0, 0, 0); }
}
#define PK4(P, BASE, OUT) do { unsigned a0 = cvt_pk_bf16(P[BASE + 0], P[BASE + 1]), a1 = cvt_pk_bf16(P[BASE + 2], P[BASE + 3]);   \
    unsigned b0 = cvt_pk_bf16(P[BASE + 4], P[BASE + 5]), b1 = cvt_pk_bf16(P[BASE + 6], P[BASE + 7]);                              \
    auto r0 = __builtin_amdgcn_permlane32_swap(a0, b0, false, false); auto r1 = __builtin_amdgcn_permlane32_swap(a1, b1, false, false); \
    u32x4 w = {r0[0], r1[0], r0[1], r1[1]}; OUT = *reinterpret_cast<bf16x8*>(&w); } while (0)
__device__ __forceinline__ float half_max(float v) { auto rr = __builtin_amdgcn_permlane32_swap(__float_as_uint(v), __float_as_uint(v), false, false); return fmaxf(__uint_as_float(rr[0]), __uint_as_float(rr[1])); }
__device__ __forceinline__ float half_sum(float v) { auto rr = __builtin_amdgcn_permlane32_swap(__float_as_uint(v), __float_as_uint(v), false, false); return __uint_as_float(rr[0]) + __uint_as_float(rr[1]); }

struct VFrag { s16x4 l0, h0, l1, h1; };
template <int D0, int HALF> __device__ __forceinline__ void v_issue(VFrag& f, int vb) {
    f.l0 = tr_read<v_rd_off(D0, 2 * HALF, 0)>(vb); f.h0 = tr_read<v_rd_off(D0, 2 * HALF, 1)>(vb); f.l1 = tr_read<v_rd_off(D0, 2 * HALF + 1, 0)>(vb); f.h1 = tr_read<v_rd_off(D0, 2 * HALF + 1, 1)>(vb);
}
#define PKV(L, H) (bf16x8){L[0], L[1], L[2], L[3], H[0], H[1], H[2], H[3]}
template <int D0, int HALF> __device__ __forceinline__ void pv_step(f32x16 (&o)[8], VFrag& cur, VFrag& nxt, int vb, bf16x8 pa0, bf16x8 pa1) {
    if constexpr (D0 < 7) { v_issue<D0 + 1, HALF>(nxt, vb); asm volatile("s_waitcnt lgkmcnt(4)" ::: "memory"); }
    else asm volatile("s_waitcnt lgkmcnt(0)" ::: "memory");
    SBAR();
    o[D0] = __builtin_amdgcn_mfma_f32_32x32x16_bf16(pa0, PKV(cur.l0, cur.h0), o[D0], 0, 0, 0);
    o[D0] = __builtin_amdgcn_mfma_f32_32x32x16_bf16(pa1, PKV(cur.l1, cur.h1), o[D0], 0, 0, 0);
    SBAR();
}
template <int HALF> __device__ __forceinline__ void pv_half(f32x16 (&o)[8], VFrag& f0, int vb, bf16x8 pa0, bf16x8 pa1) {
    VFrag f1;
    pv_step<0, HALF>(o, f0, f1, vb, pa0, pa1); pv_step<1, HALF>(o, f1, f0, vb, pa0, pa1); pv_step<2, HALF>(o, f0, f1, vb, pa0, pa1); pv_step<3, HALF>(o, f1, f0, vb, pa0, pa1);
    pv_step<4, HALF>(o, f0, f1, vb, pa0, pa1); pv_step<5, HALF>(o, f1, f0, vb, pa0, pa1); pv_step<6, HALF>(o, f0, f1, vb, pa0, pa1); pv_step<7, HALF>(o, f1, f0, vb, pa0, pa1);
}
struct DiffArgs { const bf16_t* Q; const bf16_t* K; const bf16_t* V; const bf16_t* SZ; bf16_t* YG; const float* subln_g; float lam, lam_scale; };
__device__ __forceinline__ void diff_tile(f32x16 (&o)[8], const LAS unsigned char* Ks, int vb, const bf16x8 (&qr)[8], LAS float* wsc,
                                          float& m_reg, float& l_reg, float slC, float C, int lim0  , bool diag, int r32, int hi) {
    f32x16 p0 = (f32x16){}, p1 = (f32x16){};
    {
        bf16x8 ka[2], kb[2];
        ka[0] = *(const LAS bf16x8*)(Ks + KSWZ(r32, (hi * 8) * 2)); kb[0] = *(const LAS bf16x8*)(Ks + KSWZ(32 + r32, (hi * 8) * 2));
#pragma unroll
        for (int d0 = 0; d0 < 8; ++d0) {
            if (d0 < 7) { const int cb = ((d0 + 1) * 16 + hi * 8) * 2;
                ka[(d0 + 1) & 1] = *(const LAS bf16x8*)(Ks + KSWZ(r32, cb)); kb[(d0 + 1) & 1] = *(const LAS bf16x8*)(Ks + KSWZ(32 + r32, cb)); }
            SBAR();
            p0 = __builtin_amdgcn_mfma_f32_32x32x16_bf16(ka[d0 & 1], qr[d0], p0, 0, 0, 0);
            p1 = __builtin_amdgcn_mfma_f32_32x32x16_bf16(kb[d0 & 1], qr[d0], p1, 0, 0, 0);
            SBAR(); }
    }
    VFrag vf0; v_issue<0, 0>(vf0, vb);
    if (diag) {
#pragma unroll
        for (int r = 0; r < 16; ++r) { const int kp = (r & 3) + 8 * (r >> 2); if (kp > lim0) p0[r] = -INFINITY; if (kp + 32 > lim0) p1[r] = -INFINITY; } }
    float pmax = p0[0];
#pragma unroll
    for (int r = 1; r < 16; ++r) pmax = fmaxf(pmax, p0[r]);
#pragma unroll
    for (int r = 0; r < 16; ++r) pmax = fmaxf(pmax, p1[r]);
    pmax = half_max(pmax) * C;
    float alpha = 1.f;
    if (!__all(pmax - m_reg <= 6.0f)) { const float mn = fmaxf(m_reg, pmax); alpha = __builtin_amdgcn_exp2f(m_reg - mn); m_reg = mn; }
    const float kb0 = -fmaf(slC, (float)lim0, m_reg), kb1 = fmaf(slC, 32.0f, kb0);
    float ps0 = 0.f, ps1 = 0.f;
#pragma unroll
    for (int r = 0; r < 16; ++r) { const float kpf = (float)((r & 3) + 8 * (r >> 2));
        p0[r] = __builtin_amdgcn_exp2f(fmaf(p0[r], C, fmaf(kpf, slC, kb0))); ps0 += p0[r];
        p1[r] = __builtin_amdgcn_exp2f(fmaf(p1[r], C, fmaf(kpf, slC, kb1))); ps1 += p1[r]; }
    const float ps = half_sum(ps0 + ps1); l_reg = l_reg * alpha + ps;
    bf16x8 pa0, pa1, pa2, pa3; PK4(p0, 0, pa0); PK4(p0, 8, pa1); PK4(p1, 0, pa2); PK4(p1, 8, pa3);
    if (__any(alpha < 1.f)) { if (hi == 0) wsc[r32] = alpha; asm volatile("s_waitcnt lgkmcnt(0)" ::: "memory");
#pragma unroll
        for (int r = 0; r < 16; ++r) { const float a = wsc[crow(r, hi)];
#pragma unroll
            for (int d = 0; d < 8; ++d) o[d][r] *= a; } }
    SBAR();
    pv_half<0>(o, vf0, vb, pa0, pa1);
    VFrag vf1; v_issue<0, 1>(vf1, vb); SBAR();
    pv_half<1>(o, vf1, vb, pa2, pa3);
}
__device__ __forceinline__ void diff_unit(LAS unsigned char* lds, LAS float* wsc_all, const DiffArgs& A, int b, int h, int qb, int rev, int wid, int lane) {
    asm volatile("" : "+v"(lane));
    LAS float* wsc = wsc_all + wid * 64;
    const int r32 = lane & 31, hi = lane >> 5, map = wid >> 2, w4 = wid & 3;
    const int q0 = qb * 128, wrow0 = q0 + 32 * w4;
    const size_t rowb = (size_t)b * SEQ;
    const float slope = (h < 16) ? __builtin_amdgcn_exp2f(-0.5f * (float)(h + 1)) : __builtin_amdgcn_exp2f(-0.25f * (float)(2 * (h - 16) + 1));
    const float C = 0.08838834764831845f * LOG2E, slC = slope * LOG2E;
    const bf16_t* K0 = A.K + (((size_t)(b * 8) * NCT6 + h) << 16); const bf16_t* Vb = A.V + (((size_t)(b * 8) * NCT6 + h) << 16);
#define TOFF(jt_) ((((size_t)((jt_) >> 2) * NCT6) << 16) + (size_t)(((jt_) & 3) * 64 * 256))
    const unsigned ko0 = dma_k_off(0, 256, wid, lane), ko1 = ko0 + 16384u;
    unsigned vo[4]; vo[0] = dma_v_off(0, 256, wid, lane);
#pragma unroll
    for (int i = 1; i < 4; ++i) vo[i] = vo[0] + (unsigned)i * 8192u;
    const int NT = 2 * qb + 2;
    const int vbase = (int)(unsigned)(uintptr_t)(lds) + v_rd_base(lane);
    { const size_t ro = TOFF(rev ? NT - 1 : 0); glds_tile(K0 + ro, K0 + 128 + ro, Vb + ro, ko0, ko1, vo[0], vo[1], vo[2], vo[3], (unsigned)(uintptr_t)lds + (unsigned)wid * 1024u); }
    bf16x8 qr[8];
    { const bf16_t* Qw = A.Q + blk((int)rowb + wrow0 + r32, h * 256 + map * 128 + hi * 8, NCT6);
#pragma unroll
      for (int d0 = 0; d0 < 8; ++d0) qr[d0] = *(const bf16x8*)(Qw + d0 * 16); }
    asm volatile("" :: "v"(qr[0]), "v"(qr[1]), "v"(qr[2]), "v"(qr[3]), "v"(qr[4]), "v"(qr[5]), "v"(qr[6]), "v"(qr[7]));
    float m_reg = -1e30f, l_reg = 0.f; f32x16 o[8];
#pragma unroll
    for (int d = 0; d < 8; ++d) o[d] = (f32x16){};
    for (int st = 0; st < NT; ++st) {
        const int jt = rev ? NT - 1 - st : st; const unsigned buf = (unsigned)(st & 1) * 65536u;
        asm volatile("s_waitcnt vmcnt(0)" ::: "memory"); __builtin_amdgcn_s_barrier(); asm volatile("" ::: "memory");
        if (st + 1 < NT) { const unsigned nb = 65536u - buf; const size_t ro = TOFF(rev ? jt - 1 : jt + 1);
            int ln = lane; asm volatile("" : "+v"(ln));
            const unsigned k0o = dma_k_off(0, 256, wid, ln), k1o = k0o + 16384u; unsigned v2[4]; v2[0] = dma_v_off(0, 256, wid, ln);
#pragma unroll
            for (int i = 1; i < 4; ++i) v2[i] = v2[0] + (unsigned)i * 8192u;
            glds_tile(K0 + ro, K0 + 128 + ro, Vb + ro, k0o, k1o, v2[0], v2[1], v2[2], v2[3], (unsigned)(uintptr_t)lds + nb + (unsigned)wid * 1024u);
        }
        const LAS unsigned char* Ks = lds + buf + (unsigned)map * 16384u; const int vb = vbase + (int)buf + 32768;
        const int lim0 = wrow0 + r32 - 64 * jt - 4 * hi;
        if (64 * jt <= wrow0 + 31)
            diff_tile(o, Ks, vb, qr, wsc, m_reg, l_reg, slC, C, lim0, 64 * jt + 63 > wrow0, r32, hi);
    }
    if (hi == 0) wsc[32 + r32] = l_reg;
    asm volatile("s_waitcnt lgkmcnt(0)" ::: "memory");
    float rli[16];
#pragma unroll
    for (int r = 0; r < 16; r += 4) { const f32x4 l4 = *(const LAS f32x4*)(wsc + 32 + 8 * (r >> 2) + 4 * hi);
#pragma unroll
        for (int e = 0; e < 4; ++e) rli[r + e] = __builtin_amdgcn_rcpf(l4[e]); }
    asm volatile("s_waitcnt lgkmcnt(0)" ::: "memory"); __builtin_amdgcn_s_barrier(); asm volatile("" ::: "memory");
    LAS f32x4* Xo = (LAS f32x4*)lds + (size_t)(w4 * 2 + map) * 1024 + lane;
    const LAS f32x4* Xi = (const LAS f32x4*)lds + (size_t)(w4 * 2 + (map ^ 1)) * 1024 + lane;
    float v[4][16];
    if (map == 0) {
#pragma unroll
        for (int dd = 0; dd < 4; ++dd)
#pragma unroll
            for (int r = 0; r < 16; r += 4) { Xo[(dd * 4 + (r >> 2)) * 64] = (f32x4){o[4 + dd][r] * rli[r], o[4 + dd][r + 1] * rli[r + 1], o[4 + dd][r + 2] * rli[r + 2], o[4 + dd][r + 3] * rli[r + 3]};
#pragma unroll
                for (int e = 0; e < 4; ++e) v[dd][r + e] = o[dd][r + e] * rli[r + e]; }
    } else {
#pragma unroll
        for (int dd = 0; dd < 4; ++dd)
#pragma unroll
            for (int r = 0; r < 16; r += 4) { Xo[(dd * 4 + (r >> 2)) * 64] = (f32x4){o[dd][r] * rli[r], o[dd][r + 1] * rli[r + 1], o[dd][r + 2] * rli[r + 2], o[dd][r + 3] * rli[r + 3]};
#pragma unroll
                for (int e = 0; e < 4; ++e) v[dd][r + e] = o[4 + dd][r + e] * rli[r + e]; }
    }
    asm volatile("s_waitcnt lgkmcnt(0)" ::: "memory"); __builtin_amdgcn_s_barrier(); asm volatile("" ::: "memory");
    const int cbase = h * 256 + map * 128, c8 = (lane & 15) * 8, rq = lane >> 4;
    u32x4 gz[8]; float gsub[4];
#pragma unroll
    for (int i = 0; i < 8; ++i) gz[i] = *(const u32x4*)(A.SZ + blk((int)rowb + wrow0 + 4 * i + rq, cbase + c8, NCT8));
#pragma unroll
    for (int dd = 0; dd < 4; ++dd) gsub[dd] = A.subln_g[map * 128 + dd * 32 + r32];
    float ss[16];
#pragma unroll
    for (int r = 0; r < 16; ++r) ss[r] = 0.f;
#pragma unroll
    for (int dd = 0; dd < 4; ++dd)
#pragma unroll
        for (int r = 0; r < 16; r += 4) { const f32x4 x4 = Xi[(dd * 4 + (r >> 2)) * 64];
#pragma unroll
            for (int e = 0; e < 4; ++e) { const float x = x4[e]; const float y = map ? (x - A.lam * v[dd][r + e]) : (v[dd][r + e] - A.lam * x); v[dd][r + e] = y; ss[r + e] += y * y; } }
#define ROR_ADD(X, N) X += __builtin_bit_cast(float, __builtin_amdgcn_update_dpp(0, __builtin_bit_cast(int, X), 0x120 | (N), 0xf, 0xf, false))
#pragma unroll
    for (int r = 0; r < 16; ++r) { float sq = ss[r];
        ROR_ADD(sq, 8); ROR_ADD(sq, 4); ROR_ADD(sq, 2); ROR_ADD(sq, 1);
        sq += __shfl_xor(sq, 16);
        ss[r] = sq; }
#undef ROR_ADD
    if (r32 == 0) {
#pragma unroll
        for (int r = 0; r < 16; r += 4) *(LAS f32x4*)(wsc + 32 + hi * 16 + r) = (f32x4){ss[r], ss[r + 1], ss[r + 2], ss[r + 3]}; }
    asm volatile("s_waitcnt lgkmcnt(0)" ::: "memory"); __builtin_amdgcn_s_barrier(); asm volatile("" ::: "memory");
    { const LAS float* pw = wsc_all + (wid ^ 4) * 64 + 32 + hi * 16;
#pragma unroll
      for (int r = 0; r < 16; r += 4) { const f32x4 p4 = *(const LAS f32x4*)(pw + r);
#pragma unroll
          for (int e = 0; e < 4; ++e) ss[r + e] = __builtin_amdgcn_rsqf((ss[r + e] + p4[e]) * (1.0f / 256.0f) + SUBLN_EPS) * A.lam_scale; } }
    LAS float* T = (LAS float*)lds + wid * 4096;
    { LAS float* Te = T + (4 * hi) * 128 + r32 + hi * 32; LAS float* To = T + (4 * hi) * 128 + r32 - hi * 32;
#pragma unroll
      for (int dd = 0; dd < 4; ++dd)
#pragma unroll
          for (int r = 0; r < 16; ++r) ((dd & 1) ? To : Te)[((r & 3) + 8 * (r >> 2)) * 128 + dd * 32] = v[dd][r] * ss[r] * gsub[dd]; }
    asm volatile("s_waitcnt lgkmcnt(0)" ::: "memory");
    f32x4 ya[8], yb[8];
#pragma unroll
    for (int i = 0; i < 8; ++i) { const LAS float* sp = T + (4 * i + rq) * 128 + (c8 ^ ((i & 1) * 32)); ya[i] = *(const LAS f32x4*)sp; yb[i] = *(const LAS f32x4*)(sp + 4); }
    asm volatile("s_waitcnt lgkmcnt(0)" ::: "memory"); __builtin_amdgcn_s_barrier(); asm volatile("" ::: "memory");
#pragma unroll
    for (int i = 0; i < 8; ++i) { u32x4 w;
        w.x = cvt_pk_bf16(ya[i].x * bf_lo(gz[i].x), ya[i].y * bf_hi(gz[i].x)); w.y = cvt_pk_bf16(ya[i].z * bf_lo(gz[i].y), ya[i].w * bf_hi(gz[i].y));
        w.z = cvt_pk_bf16(yb[i].x * bf_lo(gz[i].z), yb[i].y * bf_hi(gz[i].z)); w.w = cvt_pk_bf16(yb[i].z * bf_lo(gz[i].w), yb[i].w * bf_hi(gz[i].w));
        *(u32x4*)(A.YG + blk((int)rowb + wrow0 + 4 * i + rq, cbase + c8, NCT8)) = w; }
}

#undef TOFF
struct MemArgs { const bf16_t* QM; const bf16_t* KV; const bf16_t* SZ; bf16_t* YG; };
__device__ __forceinline__ void mem_unit(LAS unsigned char* lds, LAS float* wsc_all, const MemArgs& A, int b, int h, int qb, int half, int wid, int lane) {
    asm volatile("" : "+v"(lane));
    LAS float* wsc = wsc_all + wid * 64;
    const int r32 = lane & 31, hi = lane >> 5;
    const size_t qrow = (size_t)b * SEQ + qb * 256 + wid * 32;
    const bf16_t* Kb = A.KV + (size_t)b * MEMLEN * LD4 + h * MHD; const bf16_t* Vb = A.KV + (size_t)b * MEMLEN * LD4 + DMEMB + h * MHD + half * 256;
    const float C = 0.04419417382415922f * LOG2E;
    f32x16 p[8];
#pragma unroll
    for (int i = 0; i < 8; ++i) p[i] = (f32x16){};
    bf16x8 qr[8];
    asm volatile("" ::: "memory"); __builtin_amdgcn_s_barrier(); asm volatile("" ::: "memory");
    { int ln = lane; asm volatile("" : "+v"(ln)); const unsigned ko0 = dma_k_off(0, LD4, wid, ln), ko1 = dma_k_off(1, LD4, wid, ln);
#pragma unroll
      for (int kt = 0; kt < 4; ++kt) dma_k(lds, (unsigned)kt * 16384u, Kb + (size_t)kt * 64 * LD4, ko0, ko1, wid); }
    const bf16_t* Qw = A.QM + blk((int)qrow + r32, h * MHD + hi * 8, NCT2);
#pragma unroll
    for (int d0 = 0; d0 < 8; ++d0) qr[d0] = *(const bf16x8*)(Qw + d0 * 16);
#pragma unroll
    for (int c = 0; c < 4; ++c) {
        asm volatile("s_waitcnt vmcnt(0)" ::: "memory");
        asm volatile("" : "+v"(qr[0]), "+v"(qr[1]), "+v"(qr[2]), "+v"(qr[3]), "+v"(qr[4]), "+v"(qr[5]), "+v"(qr[6]), "+v"(qr[7]));
        __builtin_amdgcn_s_barrier(); asm volatile("" ::: "memory");
        if (c < 3) { int ln = lane; asm volatile("" : "+v"(ln)); const unsigned ko0 = dma_k_off(0, LD4, wid, ln), ko1 = dma_k_off(1, LD4, wid, ln);
#pragma unroll
            for (int kt = 0; kt < 4; ++kt) dma_k(lds, (unsigned)((c + 1) & 1) * 65536u + (unsigned)kt * 16384u, Kb + (size_t)kt * 64 * LD4 + (c + 1) * 128, ko0, ko1, wid);
        }
        const LAS unsigned char* Kc = lds + (c & 1) * 65536;
#pragma unroll
        for (int d0 = 0; d0 < 8; ++d0) { const int cb = (d0 * 16 + hi * 8) * 2;
#pragma unroll
            for (int kt = 0; kt < 4; ++kt) {
                const bf16x8 b0 = *(const LAS bf16x8*)(Kc + kt * 16384 + KSWZ(r32, cb));
                const bf16x8 b1 = *(const LAS bf16x8*)(Kc + kt * 16384 + KSWZ(32 + r32, cb));
                p[2 * kt] = __builtin_amdgcn_mfma_f32_32x32x16_bf16(b0, qr[d0], p[2 * kt], 0, 0, 0);
                p[2 * kt + 1] = __builtin_amdgcn_mfma_f32_32x32x16_bf16(b1, qr[d0], p[2 * kt + 1], 0, 0, 0); }
            SBAR();
            if (c < 3) qr[d0] = *(const bf16x8*)(A.QM + blk((int)qrow + r32, h * MHD + (c + 1) * 128 + hi * 8, NCT2) + d0 * 16);
            SBAR(); }
    }
    asm volatile("" ::: "memory"); __builtin_amdgcn_s_barrier(); asm volatile("" ::: "memory");
    { int ln = lane; asm volatile("" : "+v"(ln)); unsigned vo[4];
#pragma unroll
      for (int i = 0; i < 4; ++i) vo[i] = dma_v_off(i, LD4, wid, ln);
#pragma unroll
      for (int kt = 0; kt < 4; ++kt) dma_v(lds, (unsigned)kt * 32768u, Vb + (size_t)kt * 64 * LD4, vo, wid); }
    float pmax = p[0][0];
#pragma unroll
    for (int i = 0; i < 8; ++i)
#pragma unroll
        for (int r = 0; r < 16; ++r) pmax = fmaxf(pmax, p[i][r]);
    pmax = half_max(pmax);
    const float mn = pmax * C; float ps = 0.f;
#pragma unroll
    for (int i = 0; i < 8; ++i)
#pragma unroll
        for (int r = 0; r < 16; ++r) { p[i][r] = __builtin_amdgcn_exp2f(fmaf(p[i][r], C, -mn)); ps += p[i][r]; }
    ps = half_sum(ps);
    bf16x8 pa[4][4];
#pragma unroll
    for (int kt = 0; kt < 4; ++kt) { PK4(p[2 * kt], 0, pa[kt][0]); PK4(p[2 * kt], 8, pa[kt][1]); PK4(p[2 * kt + 1], 0, pa[kt][2]); PK4(p[2 * kt + 1], 8, pa[kt][3]); }
    f32x16 o[8];
#pragma unroll
    for (int d = 0; d < 8; ++d) o[d] = (f32x16){};
    const int vbase = (int)(unsigned)(uintptr_t)(lds) + v_rd_base(lane);
    asm volatile("s_waitcnt vmcnt(0)" ::: "memory"); __builtin_amdgcn_s_barrier(); asm volatile("" ::: "memory");
#pragma unroll
    for (int kt = 0; kt < 4; ++kt) pv_all(o, vbase + kt * 32768, pa[kt][0], pa[kt][1], pa[kt][2], pa[kt][3]);
    if (hi == 0) wsc[32 + r32] = ps;
    asm volatile("s_waitcnt lgkmcnt(0)" ::: "memory");
    float rli[16];
#pragma unroll
    for (int r = 0; r < 16; r += 4) { const f32x4 l4 = *(const LAS f32x4*)(wsc + 32 + 8 * (r >> 2) + 4 * hi);
#pragma unroll
        for (int e = 0; e < 4; ++e) rli[r + e] = __builtin_amdgcn_rcpf(l4[e]); }
    asm volatile("" ::: "memory"); __builtin_amdgcn_s_barrier(); asm volatile("" ::: "memory");
    const int c8 = (lane & 15) * 8, rq = lane >> 4;
    LAS float* T = (LAS float*)lds + wid * 4096;
    LAS float* Te = T + (4 * hi) * 128 + r32 + hi * 32; LAS float* To = T + (4 * hi) * 128 + r32 - hi * 32;
#pragma unroll
    for (int dq = 0; dq < 8; dq += 4) {
        const int cbase = DMIX + h * MHD + half * 256 + dq * 32;
        u32x4 gz[8];
#pragma unroll
        for (int i = 0; i < 8; ++i) gz[i] = *(const u32x4*)(A.SZ + blk((int)qrow + 4 * i + rq, cbase + c8, NCT8));
#pragma unroll
        for (int dd = 0; dd < 4; ++dd)
#pragma unroll
            for (int r = 0; r < 16; ++r) ((dd & 1) ? To : Te)[((r & 3) + 8 * (r >> 2)) * 128 + dd * 32] = o[dq + dd][r] * rli[r];
        asm volatile("s_waitcnt lgkmcnt(0)" ::: "memory");
        f32x4 ya[8], yb[8];
#pragma unroll
        for (int i = 0; i < 8; ++i) { const LAS float* sp = T + (4 * i + rq) * 128 + (c8 ^ ((i & 1) * 32)); ya[i] = *(const LAS f32x4*)sp; yb[i] = *(const LAS f32x4*)(sp + 4); }
        asm volatile("s_waitcnt lgkmcnt(0)" ::: "memory");
#pragma unroll
        for (int i = 0; i < 8; ++i) { u32x4 w;
            w.x = cvt_pk_bf16(ya[i].x * bf_lo(gz[i].x), ya[i].y * bf_hi(gz[i].x)); w.y = cvt_pk_bf16(ya[i].z * bf_lo(gz[i].y), ya[i].w * bf_hi(gz[i].y));
            w.z = cvt_pk_bf16(yb[i].x * bf_lo(gz[i].z), yb[i].y * bf_hi(gz[i].z)); w.w = cvt_pk_bf16(yb[i].z * bf_lo(gz[i].w), yb[i].w * bf_hi(gz[i].w));
            *(u32x4*)(A.YG + blk((int)qrow + 4 * i + rq, cbase + c8, NCT8)) = w; }
    }
    asm volatile("s_waitcnt lgkmcnt(0)" ::: "memory"); __builtin_amdgcn_s_barrier(); asm volatile("" ::: "memory");
}
#undef PK4
}

constexpr size_t MiB = 1u << 20;
constexpr size_t ws_up(size_t x) { return (x + MiB - 1) / MiB * MiB; }
constexpr size_t WS_CTL = 0, CTL_ZERO_BYTES = 1 * MiB;
constexpr size_t WS_WIN0T = 2 * MiB, WS_POOLWT = WS_WIN0T + ws_up((size_t)N0 * LD4 * 2), WS_WKV0T = WS_POOLWT + ws_up((size_t)4 * PGRP * LDP * 2), WS_WKV1T = WS_WKV0T + ws_up((size_t)DM * LD4 * 2);
constexpr size_t WS_WOUT0T = WS_WKV1T + ws_up((size_t)DM * LD4 * 2), WS_WOUT1T = WS_WOUT0T + ws_up((size_t)DM * LD8 * 2), WS_WIN1T = WS_WOUT1T + ws_up((size_t)DM * LD8 * 2);
constexpr size_t WS_H = WS_WIN1T + ws_up((size_t)N1 * LD4 * 2), WS_MN0 = WS_H + ws_up((size_t)M * LD4 * 2), WS_MN1 = WS_MN0 + ws_up((size_t)MROWS * LD4 * 2), WS_KV0 = WS_MN1 + ws_up((size_t)MROWS * LD4 * 2), WS_KV1 = WS_KV0 + ws_up((size_t)MROWS * LD4 * 2);
constexpr size_t WS_U = WS_KV1 + ws_up((size_t)MROWS * LD4 * 2), WS_PL = WS_U + ws_up((size_t)M * LD6 * 2), WS_V = WS_PL + ws_up((size_t)M * LD6 * 2), WS_QM = WS_V + ws_up((size_t)M * LD6 * 2);
constexpr size_t WS_SZ = WS_QM + ws_up((size_t)M * LD2 * 2), WS_YG = WS_SZ + ws_up((size_t)M * LD8 * 2), WS_X1 = WS_YG + ws_up((size_t)M * LD8 * 2), WS_X2 = WS_X1 + (size_t)M * DM * 4, WS_END = WS_X2 + (size_t)M * DM * 4;
static_assert(WS_END <= (size_t)1700 * MiB, "d_ws map");
constexpr int CW_BAR = 4096, CW_QUEUE = 16384, CW_ROWSS = 131072;
constexpr int RING_BYTES = 131072, WSC_OFF = RING_BYTES, MISC_OFF = WSC_OFF + 2048, LDS_BYTES = 147456;
constexpr int NWAVES = 8, NPHASE = 10;

#define XB_TMO      128
#define XB_XCNT(j)  (256  + 64 * (j))
#define XB_XSUB(j)  (1280 + 64 * (j))
#define XB_XGEN(j)  (2304 + 64 * (j))
#define XB_TOP      3328
#define XB_TOPGEN   3392
#define XCD_BAR_WORDS 3456
#define XB_SPIN_CAP (1u << 18)
__device__ __forceinline__ unsigned xb_ld(unsigned* p)              { return __hip_atomic_load(p, __ATOMIC_RELAXED, __HIP_MEMORY_SCOPE_AGENT); }
__device__ __forceinline__ unsigned xb_add(unsigned* p, unsigned v) { return __hip_atomic_fetch_add(p, v, __ATOMIC_RELAXED, __HIP_MEMORY_SCOPE_AGENT); }
__device__ __forceinline__ unsigned xb_xcc_id() { return (unsigned)__builtin_amdgcn_s_getreg((3 << 11) | 20) & 0xFu; }
#define XB_SPIN(cond, bar) do { unsigned _sp = 0; while (cond) { __builtin_amdgcn_s_sleep(1); \
    if ((++_sp & 255u) == 0u) { if (xb_ld(&(bar)[XB_TMO])) break; if (_sp > XB_SPIN_CAP) { atomicAdd(&(bar)[XB_TMO], 1u); break; } } } } while (0)
struct XcdBarrier { unsigned* bar; unsigned x; volatile LAS unsigned* st; };
__device__ __forceinline__ XcdBarrier xcd_barrier_post(unsigned* bar, volatile LAS unsigned* st) {
    XcdBarrier b; b.bar = bar; b.x = xb_xcc_id(); b.st = st;
    if (threadIdx.x == 0) (void)xb_add(&bar[XB_XCNT(b.x)], 1u);
    return b;
}
__device__ __forceinline__ void xcd_barrier_complete(unsigned* bar, unsigned x, unsigned& nloc, unsigned& nx) {
    const unsigned G = gridDim.x * gridDim.y * gridDim.z;
    unsigned sum, cnt, mine, sp = 0u;
    for (;;) {
        sum = 0u; cnt = 0u; mine = 0u;
#pragma unroll
        for (unsigned j = 0; j < 16; ++j) { const unsigned c = xb_ld(&bar[XB_XCNT(j)]); sum += c; cnt += (c > 0u) ? 1u : 0u; mine = (j == x) ? c : mine; }
        if (sum == G) break;
        __builtin_amdgcn_s_sleep(1);
        if ((++sp & 255u) == 0u) { if (xb_ld(&bar[XB_TMO])) break; if (sp > XB_SPIN_CAP) { atomicAdd(&bar[XB_TMO], 1u); break; } }
    }
    nloc = mine > 0u ? mine : 1u; nx = cnt > 0u ? cnt : 1u;
}
__device__ __forceinline__ void xcd_barrier(const XcdBarrier& b) {
    asm volatile("s_waitcnt vmcnt(0)" ::: "memory");
    __syncthreads();
    if (threadIdx.x == 0) {
        unsigned* bar = b.bar;
        __builtin_amdgcn_s_waitcnt(0);
        unsigned nloc = b.st[0], nx = b.st[1];
        if (nloc == 0u) { xcd_barrier_complete(bar, b.x, nloc, nx); b.st[0] = nloc; b.st[1] = nx; }
        const unsigned old = xb_add(&bar[XB_XSUB(b.x)], 1u);
        const unsigned gen = old / nloc;
        if (old + 1u == (gen + 1u) * nloc) {
            __builtin_amdgcn_fence(__ATOMIC_RELEASE, "agent");
            asm volatile("s_waitcnt vmcnt(0)" ::: "memory");
            const unsigned og = xb_add(&bar[XB_TOP], 1u);
            const unsigned tg = og / nx;
            if (og + 1u == (tg + 1u) * nx) xb_add(&bar[XB_TOPGEN], 1u);
            else XB_SPIN(xb_ld(&bar[XB_TOPGEN]) == tg, bar);
            __builtin_amdgcn_fence(__ATOMIC_ACQUIRE, "agent");
            xb_add(&bar[XB_XGEN(b.x)], 1u);
            asm volatile("s_waitcnt vmcnt(0)" ::: "memory");
        } else {
            XB_SPIN(xb_ld(&bar[XB_XGEN(b.x)]) == gen, bar);
            __builtin_amdgcn_fence(__ATOMIC_ACQUIRE, "agent");
            asm volatile("s_waitcnt vmcnt(0)" ::: "memory");
        }
    }
    __syncthreads();
}

__device__ __forceinline__ float wave_sum(float v) {
#pragma unroll
    for (int o = 1; o < 64; o <<= 1) v += __shfl_xor(v, o);
    return v;
}
__device__ __forceinline__ unsigned f2bf(float f) { unsigned u = __builtin_bit_cast(unsigned, f); return (u + 0x7fffu + ((u >> 16) & 1u)) >> 16; }
__device__ __forceinline__ unsigned pk2(float lo, float hi) { return cvt_pk_bf16(lo, hi); }
__device__ __forceinline__ void transpose_item(const float* W, int K, int N, bf16_t* WT, int ldt, LAS float* scr, int item, int lane, const float* rowgain = nullptr) {
    const int nblk = N / 32, kb = item / nblk, nb = item % nblk, k0 = 64 * kb, n0 = 32 * nb;
    float wv[32];
#pragma unroll
    for (int i = 0; i < 32; ++i) wv[i] = W[(size_t)(k0 + 2 * i + (lane >> 5)) * N + n0 + (lane & 31)];
    if (rowgain) {
#pragma unroll
        for (int i = 0; i < 32; ++i) wv[i] *= rowgain[k0 + 2 * i + (lane >> 5)]; }
#pragma unroll
    for (int i = 0; i < 32; ++i) scr[(2 * i + (lane >> 5)) * 33 + (lane & 31)] = wv[i];
    asm volatile("s_waitcnt lgkmcnt(0)" ::: "memory");
    const int c = lane & 7;
#pragma unroll
    for (int j = 0; j < 4; ++j) { const int n = (lane >> 3) + 8 * j; const LAS float* s = scr + (8 * c) * 33 + n;
        u32x4 o; o.x = pk2(s[0 * 33], s[1 * 33]); o.y = pk2(s[2 * 33], s[3 * 33]); o.z = pk2(s[4 * 33], s[5 * 33]); o.w = pk2(s[6 * 33], s[7 * 33]);
        *(u32x4*)(WT + (size_t)(n0 + n) * ldt + k0 + 8 * c) = o; }
    asm volatile("s_waitcnt lgkmcnt(0)" ::: "memory");
}
struct TrDesc { const float* W; bf16_t* WT; const float* gain; int N, ldt, k0, n0, nkt; };
__device__ __forceinline__ void tr_set(TrDesc& d, const float* W, int N, bf16_t* WT, int ldt, int item, const float* gain, int nkt = 0) {
    const int nblk = N / 32, kb = item / nblk, nb = item % nblk; d.W = W; d.WT = WT; d.gain = gain; d.N = N; d.ldt = ldt; d.k0 = 64 * kb; d.n0 = 32 * nb; d.nkt = nkt;
}
__device__ __forceinline__ void tr_load(const TrDesc& d, float (&wv)[32], int lane) {
#pragma unroll
    for (int i = 0; i < 32; ++i) wv[i] = d.W[(size_t)(d.k0 + 2 * i + (lane >> 5)) * d.N + d.n0 + (lane & 31)];
}
__device__ __forceinline__ void tr_finish(const TrDesc& d, float (&wv)[32], LAS float* scr, int lane) {
    if (d.gain) {
#pragma unroll
        for (int i = 0; i < 32; ++i) wv[i] *= d.gain[d.k0 + 2 * i + (lane >> 5)]; }
#pragma unroll
    for (int i = 0; i < 32; ++i) scr[(2 * i + (lane >> 5)) * 33 + (lane & 31)] = wv[i];
    asm volatile("s_waitcnt lgkmcnt(0)" ::: "memory");
    const int c = lane & 7;
#pragma unroll
    for (int j = 0; j < 4; ++j) { const int n = (lane >> 3) + 8 * j; const LAS float* sp = scr + (8 * c) * 33 + n;
        u32x4 o; o.x = pk2(sp[0 * 33], sp[1 * 33]); o.y = pk2(sp[2 * 33], sp[3 * 33]); o.z = pk2(sp[4 * 33], sp[5 * 33]); o.w = pk2(sp[6 * 33], sp[7 * 33]);
        const int nn = d.n0 + n, kk = d.k0 + 8 * c;
        bf16_t* dst = d.nkt ? d.WT + (((size_t)(nn >> 8) * d.nkt + (kk >> 8)) << 16) + ((nn & 255) << 8) + (kk & 255) : d.WT + (size_t)nn * d.ldt + kk;
        *(u32x4*)dst = o; }
    asm volatile("s_waitcnt lgkmcnt(0)" ::: "memory");
}
__device__ __forceinline__ void rms_row_bf16(const float* xrow, const float* g0, bf16_t* o0, const float* g1, bf16_t* o1, int lane) {
    const f32x4* xr = (const f32x4*)xrow + lane; f32x4 v[16]; float s = 0.f;
#pragma unroll
    for (int j = 0; j < 16; ++j) { v[j] = xr[64 * j]; s += (v[j].x * v[j].x + v[j].y * v[j].y) + (v[j].z * v[j].z + v[j].w * v[j].w); }
    const float rs = __builtin_amdgcn_rsqf(wave_sum(s) * (1.0f / DM) + RMS_EPS);
#pragma unroll
    for (int j = 0; j < 16; ++j) { const f32x4 gg = ((const f32x4*)g0)[lane + 64 * j]; const f32x4 y = v[j] * rs * gg;
        u32x2 w; w.x = pk2(y.x, y.y); w.y = pk2(y.z, y.w); ((u32x2*)o0)[lane + 64 * j] = w; }
    if (o1) {
#pragma unroll
        for (int j = 0; j < 16; ++j) { const f32x4 gg = ((const f32x4*)g1)[lane + 64 * j]; const f32x4 y = v[j] * rs * gg;
            u32x2 w; w.x = pk2(y.x, y.y); w.y = pk2(y.z, y.w); ((u32x2*)o1)[lane + 64 * j] = w; }
    }
}
__device__ __forceinline__ void rms_row2_bf16(const float* xa, const float* xb, const float* g0, bf16_t* oa, bf16_t* ob, int lane) {
    const f32x4* xra = (const f32x4*)xa + lane; const f32x4* xrb = (const f32x4*)xb + lane; f32x4 va[16], vb[16]; float sa = 0.f, sb = 0.f;
#pragma unroll
    for (int j = 0; j < 16; ++j) va[j] = xra[64 * j];
#pragma unroll
    for (int j = 0; j < 16; ++j) vb[j] = xrb[64 * j];
#pragma unroll
    for (int j = 0; j < 16; ++j) sa += (va[j].x * va[j].x + va[j].y * va[j].y) + (va[j].z * va[j].z + va[j].w * va[j].w);
#pragma unroll
    for (int j = 0; j < 16; ++j) sb += (vb[j].x * vb[j].x + vb[j].y * vb[j].y) + (vb[j].z * vb[j].z + vb[j].w * vb[j].w);
    const float ra = __builtin_amdgcn_rsqf(wave_sum(sa) * (1.0f / DM) + RMS_EPS), rb = __builtin_amdgcn_rsqf(wave_sum(sb) * (1.0f / DM) + RMS_EPS);
#pragma unroll
    for (int j = 0; j < 16; ++j) { const f32x4 gg = ((const f32x4*)g0)[lane + 64 * j]; const f32x4 ya = va[j] * ra * gg, yb = vb[j] * rb * gg;
        u32x2 w; w.x = pk2(ya.x, ya.y); w.y = pk2(ya.z, ya.w); ((u32x2*)oa)[lane + 64 * j] = w;
        u32x2 z; z.x = pk2(yb.x, yb.y); z.y = pk2(yb.z, yb.w); ((u32x2*)ob)[lane + 64 * j] = z; }
}
__device__ __forceinline__ void rms_row_f32(const float* xrow, const float* g, float* orow, int lane) {
    const f32x4* xr = (const f32x4*)xrow + lane; f32x4 v[16]; float s = 0.f;
#pragma unroll
    for (int j = 0; j < 16; ++j) { v[j] = xr[64 * j]; s += (v[j].x * v[j].x + v[j].y * v[j].y) + (v[j].z * v[j].z + v[j].w * v[j].w); }
    const float rs = __builtin_amdgcn_rsqf(wave_sum(s) * (1.0f / DM) + RMS_EPS);
#pragma unroll
    for (int j = 0; j < 16; ++j) { const f32x4 gg = ((const f32x4*)g)[lane + 64 * j]; ((f32x4*)orow)[lane + 64 * j] = v[j] * rs * gg; }
}
__device__ __forceinline__ void final_row(const bf16_t* xrow, const float* rowss, const float* g, float* orow, int lane) {
    const float rs = __builtin_amdgcn_rsqf(__hip_atomic_load(rowss, __ATOMIC_RELAXED, __HIP_MEMORY_SCOPE_AGENT) * (1.0f / DM) + RMS_EPS);
#pragma unroll
    for (int j = 0; j < 8; ++j) { const u32x4 w = ((const u32x4*)xrow)[lane + 64 * j]; const f32x4 g0 = ((const f32x4*)g)[2 * (lane + 64 * j)], g1 = ((const f32x4*)g)[2 * (lane + 64 * j) + 1];
        ((f32x4*)orow)[2 * (lane + 64 * j)] = (f32x4){bf_lo(w.x), bf_hi(w.x), bf_lo(w.y), bf_hi(w.y)} * rs * g0;
        ((f32x4*)orow)[2 * (lane + 64 * j) + 1] = (f32x4){bf_lo(w.z), bf_hi(w.z), bf_lo(w.w), bf_hi(w.w)} * rs * g1; }
}
__device__ __forceinline__ void final_row2(const bf16_t* xa, const bf16_t* xb, const float* ssa, const float* ssb, const float* g, float* oa, float* ob, int lane) {
    u32x4 wa[8], wb[8];
#pragma unroll
    for (int j = 0; j < 8; ++j) wa[j] = ((const u32x4*)xa)[lane + 64 * j];
#pragma unroll
    for (int j = 0; j < 8; ++j) wb[j] = ((const u32x4*)xb)[lane + 64 * j];
    const float ra = __builtin_amdgcn_rsqf(__hip_atomic_load(ssa, __ATOMIC_RELAXED, __HIP_MEMORY_SCOPE_AGENT) * (1.0f / DM) + RMS_EPS);
    const float rb = __builtin_amdgcn_rsqf(__hip_atomic_load(ssb, __ATOMIC_RELAXED, __HIP_MEMORY_SCOPE_AGENT) * (1.0f / DM) + RMS_EPS);
#pragma unroll
    for (int j = 0; j < 8; ++j) { const f32x4 g0 = ((const f32x4*)g)[2 * (lane + 64 * j)], g1 = ((const f32x4*)g)[2 * (lane + 64 * j) + 1];
        ((f32x4*)oa)[2 * (lane + 64 * j)] = (f32x4){bf_lo(wa[j].x), bf_hi(wa[j].x), bf_lo(wa[j].y), bf_hi(wa[j].y)} * ra * g0;
        ((f32x4*)oa)[2 * (lane + 64 * j) + 1] = (f32x4){bf_lo(wa[j].z), bf_hi(wa[j].z), bf_lo(wa[j].w), bf_hi(wa[j].w)} * ra * g1;
        ((f32x4*)ob)[2 * (lane + 64 * j)] = (f32x4){bf_lo(wb[j].x), bf_hi(wb[j].x), bf_lo(wb[j].y), bf_hi(wb[j].y)} * rb * g0;
        ((f32x4*)ob)[2 * (lane + 64 * j) + 1] = (f32x4){bf_lo(wb[j].z), bf_hi(wb[j].z), bf_lo(wb[j].w), bf_hi(wb[j].w)} * rb * g1; }
}
__device__ __forceinline__ void unpack8(const u32x4 w, float (&f)[8]) { f[0] = bf_lo(w.x); f[1] = bf_hi(w.x); f[2] = bf_lo(w.y); f[3] = bf_hi(w.y); f[4] = bf_lo(w.z); f[5] = bf_hi(w.z); f[6] = bf_lo(w.w); f[7] = bf_hi(w.w); }
#define UB(t_) (ub + (((size_t)((t_) >> 8) * NCT6) << 16) + (size_t)(((t_) & 255) << 8))
template <int W> __device__ __forceinline__ void pool_block(const bf16_t* ub, bf16_t* pb, int t0) {
    constexpr int NR = W - 1 + 16;
    u32x4 row[NR];
    if (t0 == 0) {
#pragma unroll
        for (int i = 0; i < NR; ++i) row[i] = (i >= W - 1) ? *(const u32x4*)UB(i - (W - 1)) : (u32x4){0u, 0u, 0u, 0u};
    } else {
#pragma unroll
        for (int i = 0; i < NR; ++i) row[i] = *(const u32x4*)UB(t0 - (W - 1) + i);
    }
    float s[8];
#pragma unroll
    for (int e = 0; e < 8; ++e) s[e] = 0.f;
#pragma unroll
    for (int i = 0; i < W - 1; ++i) { float f[8]; unpack8(row[i], f);
#pragma unroll
        for (int e = 0; e < 8; ++e) s[e] += f[e]; }
#pragma unroll
    for (int k = 0; k < 16; ++k) { const int t = t0 + k;
        float cur[8]; unpack8(row[W - 1 + k], cur);
        const float inv = 1.0f / (float)((t + 1) < W ? (t + 1) : W);
        float ov[8];
#pragma unroll
        for (int e = 0; e < 8; ++e) { s[e] += cur[e]; ov[e] = s[e] * inv - cur[e]; }
        u32x4 o; o.x = pk2(ov[0], ov[1]); o.y = pk2(ov[2], ov[3]); o.z = pk2(ov[4], ov[5]); o.w = pk2(ov[6], ov[7]);
        *(u32x4*)(pb + (size_t)t * LD6) = o;
        float f[8]; unpack8(row[k], f);
#pragma unroll
        for (int e = 0; e < 8; ++e) s[e] -= f[e]; }
}
__device__ __forceinline__ void pool_items(const bf16_t* U, bf16_t* P, int gw, int ngw, int lane) {
    for (int it = gw; it < NB * 128 * 12; it += ngw) {
        const int cg = it % 12, tc = (it / 12) % 128, b = it / (12 * 128), c0 = cg * 512 + lane * 8, t0 = tc * 16;
        const bf16_t* ub = U + (((size_t)(b * 8) * NCT6 + (c0 >> 8)) << 16) + (c0 & 255); bf16_t* pb = P + (size_t)b * SEQ * LD6 + c0;
        switch (cg / 3) { case 0: pool_block<2>(ub, pb, t0); break; case 1: pool_block<4>(ub, pb, t0); break; case 2: pool_block<8>(ub, pb, t0); break; default: pool_block<16>(ub, pb, t0); break; }
    }
}
#undef UB
struct Args { const float* in[20]; float* out; unsigned char* ws; int ph_lo, ph_hi, li, pad; };
__global__ void __launch_bounds__(NWAVES * 64, 2) fwd(Args args) {
    extern __shared__ __attribute__((aligned(16))) unsigned char lds_raw[];
    LAS unsigned char* lds = (LAS unsigned char*)lds_raw;
    const int tid = threadIdx.x, lane = tid & 63, wave = __builtin_amdgcn_readfirstlane(tid >> 6);
    const int G = gridDim.x, bx = blockIdx.x;
    const int vcu = (G % 8 == 0) ? (bx % 8) * (G / 8) + bx / 8 : bx;
    volatile LAS unsigned* MISC = (volatile LAS unsigned*)(lds + MISC_OFF);
    LAS float* wsc = (LAS float*)(lds + WSC_OFF);
    unsigned char* ws = args.ws;
    unsigned* ctl = (unsigned*)(ws + WS_CTL);
    for (int u = tid; u < (LDS_BYTES - MISC_OFF) / 4; u += NWAVES * 64) ((LAS unsigned*)(lds + MISC_OFF))[u] = 0u;
    __syncthreads();
    XcdBarrier bar; bar.bar = ctl + CW_BAR; bar.x = 0; bar.st = nullptr;
    if (!MK_PER_PHASE) bar = xcd_barrier_post(ctl + CW_BAR, MISC + 8);
    const int lo = args.ph_lo, hi_ph = args.ph_hi;
#ifndef PH_MASK
#define PH_MASK 0x3ff
#endif
#define IN(k) (((PH_MASK >> (k)) & 1) && lo <= (k) && (k) < hi_ph)
#define REP(k) for (int rep_ = 0; rep_ < ((REPEAT_PHASE == (k)) ? 2 : 1); ++rep_)
#define SEAM(k) do { if (IN(k) && IN((k) + 1)) xcd_barrier(bar); } while (0)
    const float* x = args.in[0]; const float* mem = args.in[1];
    bf16_t* win0t = (bf16_t*)(ws + WS_WIN0T); bf16_t* poolwt = (bf16_t*)(ws + WS_POOLWT); bf16_t* wkv0t = (bf16_t*)(ws + WS_WKV0T); bf16_t* wout0t = (bf16_t*)(ws + WS_WOUT0T);
    bf16_t* win1t = (bf16_t*)(ws + WS_WIN1T); bf16_t* wkv1t = (bf16_t*)(ws + WS_WKV1T); bf16_t* wout1t = (bf16_t*)(ws + WS_WOUT1T);
    bf16_t* hbuf = (bf16_t*)(ws + WS_H); bf16_t* mn0 = (bf16_t*)(ws + WS_MN0); bf16_t* mn1 = (bf16_t*)(ws + WS_MN1); bf16_t* kv0 = (bf16_t*)(ws + WS_KV0); bf16_t* kv1 = (bf16_t*)(ws + WS_KV1);
    bf16_t* ubuf = (bf16_t*)(ws + WS_U); bf16_t* plbuf = (bf16_t*)(ws + WS_PL); bf16_t* vbuf = (bf16_t*)(ws + WS_V); bf16_t* qmbuf = (bf16_t*)(ws + WS_QM); bf16_t* szbuf = (bf16_t*)(ws + WS_SZ);
    bf16_t* x2b = (bf16_t*)(ws + WS_X1); bf16_t* ygbuf = (bf16_t*)(ws + WS_YG);
    float* rowss1 = (float*)(ws + WS_CTL) + CW_ROWSS; float* rowss2 = rowss1 + M;
    const int gw = vcu * NWAVES + wave, NGW = G * NWAVES;

    if (IN(0)) REP(0) {
        LAS float* scr = (LAS float*)(lds + wave * 16384);
        constexpr int I_IN0 = (DM / 64) * (N0 / 32), I_PW = (PGRP / 64) * (PGRP / 32), I_KV = (DM / 64) * (DM / 32), I_OUT = (DI / 64) * (DM / 32), I_IN1 = (DM / 64) * (N1 / 32);
        for (int it = gw; it < 2 * I_KV; it += NGW) {
            if (it < I_KV) transpose_item(args.in[7], DM, DM, wkv0t, LD4, scr, it, lane); else transpose_item(args.in[17], DM, DM, wkv1t, LD4, scr, it - I_KV, lane); }
        for (int m = gw; m < MROWS; m += NGW) rms_row_bf16(mem + (size_t)m * DM, args.in[6], mn0 + (size_t)m * LD4, args.in[16], mn1 + (size_t)m * LD4, lane);
        if (!MK_PER_PHASE) xcd_barrier(bar);
        const int gh = G / 2;
        if (bx < gh) {
            pg8::Gemm g{mn0, wkv0t, LD4, LD4, DM, (size_t)(WS_MN1 - WS_MN0), (size_t)(WS_WKV1T - WS_WKV0T)}; pg8::Sched S; S.init(MROWS / 256, DM / 256, 2, gh, bx);
            pg8::EpiKV E{kv0, kv1};
            pg8::gemm_phase<pg8::EpiKV>(lds, g, S, E);
        } else {
            const int gw2 = (bx - gh) * NWAVES + wave, ngw2 = (G - gh) * NWAVES;
            for (int m = gw2; m < M; m += 2 * ngw2) {
                if (m + ngw2 < M) rms_row2_bf16(x + (size_t)m * DM, x + (size_t)(m + ngw2) * DM, args.in[2], hbuf + (size_t)m * LD4, hbuf + (size_t)(m + ngw2) * LD4, lane);
                else rms_row_bf16(x + (size_t)m * DM, args.in[2], hbuf + (size_t)m * LD4, nullptr, nullptr, lane); }
        }
        { constexpr int NQ = I_IN0 + 4 * I_PW + 2 * I_OUT + I_IN1, QSH = NQ / 8, QCH = 2; static_assert(NQ % 8 == 0 && QSH % QCH == 0, "queue shards");
          unsigned* qhead = ctl + CW_QUEUE;
#define Q_PULL(sh_) ({ unsigned v_ = 0u; if (lane == 0) v_ = __hip_atomic_fetch_add(qhead + 64 * (sh_), (unsigned)QCH, __ATOMIC_RELAXED, __HIP_MEMORY_SCOPE_AGENT); v_; })
#define TR_DECODE(d_, it_) do { int r = (it_);                                                                                                  \
            if (r < I_IN0) { tr_set(d_, args.in[3], N0, win0t, LD4, r, nullptr, DM / 256); break; } r -= I_IN0;                                                    \
            if (r < 4 * I_PW) { const int g = r / I_PW; tr_set(d_, args.in[4] + (size_t)g * PGRP * PGRP, PGRP, poolwt + (size_t)g * PGRP * LDP, LDP, r % I_PW, nullptr); break; } r -= 4 * I_PW; \
            if (r < I_OUT) { tr_set(d_, args.in[8], DM, wout0t, LD8, r, nullptr, DI / 256); break; } r -= I_OUT;                                                   \
            if (r < I_IN1) { tr_set(d_, args.in[10], N1, win1t, LD4, r, args.in[9], DM / 256); break; } r -= I_IN1;                                                \
            tr_set(d_, args.in[18], DM, wout1t, LD8, r, nullptr, DI / 256); } while (0)
          int shard = bx & 7, tried = 0; unsigned nxt_v = Q_PULL(shard);
          for (;;) {
              const unsigned cur = (unsigned)__builtin_amdgcn_readfirstlane((int)nxt_v);
              if (cur >= (unsigned)QSH) { if (++tried == 8) break; shard = (shard + 1) & 7; nxt_v = Q_PULL(shard); continue; }
              TrDesc d, e; float wv[32], wu[32]; const int base = shard * QSH + (int)cur;
              TR_DECODE(d, base); tr_load(d, wv, lane); TR_DECODE(e, base + 1); tr_load(e, wu, lane);
              nxt_v = Q_PULL(shard);
              tr_finish(d, wv, scr, lane); tr_finish(e, wu, scr, lane);
          }
#undef TR_DECODE
#undef Q_PULL
        }
    }
    SEAM(0);
    if (IN(1)) REP(1) {
        pg8::Gemm g{hbuf, win0t, LD4, 256, DM, 0, 0, 0, 1}; pg8::Sched S; S.init(M / 256, N0 / 256, 1, G, bx);
        pg8::EpiProj E{ubuf, ubuf, ubuf, qmbuf, szbuf, 24, 24, 24, 32, nullptr};
        pg8::gemm_phase<pg8::EpiProj>(lds, g, S, E);
    }
    SEAM(1);
    if (IN(2)) REP(2) { pool_items(ubuf, plbuf, gw, NGW, lane); }
    SEAM(2);
    if (IN(3)) REP(3) {
        { pg8::Gemm g{plbuf, poolwt, LD6, LDP, PGRP, (size_t)PGRP * 2, (size_t)PGRP * LDP * 2}; pg8::Sched S; S.init(M / 256, PGRP / 256, 4, G, bx);
          pg8::EpiPool E{szbuf, ygbuf, args.in[5]};
          pg8::gemm_phase<pg8::EpiPool>(lds, g, S, E); }
        { const att::MemArgs MA{qmbuf, kv0, szbuf, ygbuf};
          for (int u = bx; u < 256; u += G) att::mem_unit(lds, wsc, MA, u >> 6, (u >> 4) & 3, (u >> 1) & 7, u & 1, wave, lane); }
    }
    SEAM(3);
    if (IN(4)) REP(4) {
        pg8::Gemm g{ygbuf, wout0t, 256, 256, DI, 0, 0, 1, 1}; pg8::Sched S; S.init(M / 256, DM / 256, 1, G, bx);
        pg8::EpiResid<false> E{x, hbuf, rowss1};
        pg8::gemm_phase<pg8::EpiResid<false>>(lds, g, S, E);
    }
    SEAM(4);
    if (IN(6)) REP(6) {
        pg8::Gemm g{hbuf, win1t, LD4, 256, DM, 0, 0, 0, 1}; pg8::Sched S; S.init(M / 256, N1 / 256, 1, G, bx);
        pg8::EpiProj E{ubuf, plbuf, vbuf, qmbuf, szbuf, 24, 48, 72, 80, rowss1};
        pg8::gemm_phase<pg8::EpiProj>(lds, g, S, E);
    }
    SEAM(6);
    if (IN(7)) REP(7) {
        float d1 = args.in[11][lane] * args.in[12][lane] + args.in[11][lane + 64] * args.in[12][lane + 64];
        float d2 = args.in[13][lane] * args.in[14][lane] + args.in[13][lane + 64] * args.in[14][lane + 64];
        d1 = wave_sum(d1); d2 = wave_sum(d2);
        const float lam_init = 0.8f - 0.6f * 0.7408182206817179f;
        const float lam = __expf(d1) - __expf(d2) + lam_init;
        const att::DiffArgs DA{ubuf, plbuf, vbuf, szbuf, ygbuf, args.in[15], lam, 1.0f - lam_init};
        if (wave < 4) __builtin_amdgcn_s_setprio(1);
        for (int it = bx; it < 768; it += G) {
            const int c = it & 255, rr = it >> 8, x = c & 7, j = c >> 3, k1 = rr * 4 + (j >> 4) * 2, qbi = j & 15;
            const int bh1 = x * 12 + k1, bh2 = bh1 + 1;
            att::diff_unit(lds, wsc, DA, bh1 / NHEAD, bh1 % NHEAD, qbi, 0, wave, lane);
            att::diff_unit(lds, wsc, DA, bh2 / NHEAD, bh2 % NHEAD, 15 - qbi, 1, wave, lane);
        }
        const att::MemArgs MA{qmbuf, kv1, szbuf, ygbuf};
        for (int u = bx; u < 256; u += G) att::mem_unit(lds, wsc, MA, u >> 6, (u >> 4) & 3, (u >> 1) & 7, u & 1, wave, lane);
    }
    __builtin_amdgcn_s_setprio(0);
    SEAM(7);
    if (IN(8)) REP(8) {
        pg8::Gemm g{ygbuf, wout1t, 256, 256, DI, 0, 0, 1, 1}; pg8::Sched S; S.init(M / 256, DM / 256, 1, G, bx);
        pg8::EpiResid<true> E{hbuf, x2b, rowss2};
        pg8::gemm_phase<pg8::EpiResid<true>>(lds, g, S, E);
    }
    SEAM(8);
    if (IN(9)) REP(9) {
        for (int m = gw; m < M; m += 2 * NGW) {
            if (m + NGW < M) final_row2(x2b + (size_t)m * LD4, x2b + (size_t)(m + NGW) * LD4, rowss2 + m, rowss2 + m + NGW, args.in[19], args.out + (size_t)m * DM, args.out + (size_t)(m + NGW) * DM, lane);
            else final_row(x2b + (size_t)m * LD4, rowss2 + m, args.in[19], args.out + (size_t)m * DM, lane);
        }
    }
#undef IN
#undef SEAM
}

extern "C" void kernel_launch(void* const* d_in, const int* in_sizes, int n_in, void* d_out, int out_size, void* d_ws, size_t ws_size, hipStream_t stream) {
    static int grid = 0;
    if (grid == 0) {
        if (n_in != 20 || out_size != M * DM || ws_size < WS_END) { fprintf(stderr, "kernel_launch: unexpected shapes (n_in %d out %d ws %zu)\n", n_in, out_size, ws_size); grid = -1; return; }
        int dev = 0, cus = 0, per_cu = 0;
        if (hipGetDevice(&dev) != hipSuccess || hipDeviceGetAttribute(&cus, hipDeviceAttributeMultiprocessorCount, dev) != hipSuccess) { grid = -1; return; }
        if (hipFuncSetAttribute((const void*)fwd, hipFuncAttributeMaxDynamicSharedMemorySize, LDS_BYTES) != hipSuccess) { fprintf(stderr, "kernel_launch: hipFuncSetAttribute failed\n"); grid = -1; return; }
        if (hipOccupancyMaxActiveBlocksPerMultiprocessor(&per_cu, (const void*)fwd, NWAVES * 64, LDS_BYTES) != hipSuccess || per_cu < 1)
            fprintf(stderr, "kernel_launch: occupancy query reports %d blocks per CU\n", per_cu);
        (void)hipGetLastError();
        grid = cus;
    }
    if (grid < 0) return;
    (void)hipMemsetAsync((char*)d_ws + WS_CTL, 0, CTL_ZERO_BYTES, stream);
    Args a{};
    for (int i = 0; i < 20; ++i) a.in[i] = (const float*)d_in[i];
    a.out = (float*)d_out; a.ws = (unsigned char*)d_ws; a.pad = 0;
#if MK_PER_PHASE
    for (int p = 0; p < NPHASE; ++p) { a.ph_lo = p; a.ph_hi = p + 1; a.li = p; hipLaunchKernelGGL(fwd, dim3(grid), dim3(NWAVES * 64), LDS_BYTES, stream, a); }
#else
    a.ph_lo = 0; a.ph_hi = NPHASE; a.li = 0;
    hipLaunchKernelGGL(fwd, dim3(grid), dim3(NWAVES * 64), LDS_BYTES, stream, a);
#endif
    const hipError_t le = hipPeekAtLastError();
    if (le != hipSuccess) fprintf(stderr, "kernel_launch: launch failed: %s\n", hipGetErrorName(le));
}
```

```cpp
#include <hip/hip_runtime.h>
#include <cstdio>
#include <cstdint>

#ifndef REPEAT_PHASE
#define REPEAT_PHASE -1
#endif
#ifndef EPI_NT
#define EPI_NT 0
#endif
#ifndef PG8_SP2
#define PG8_SP2 1
#endif
#ifndef MK_PER_PHASE
#define MK_PER_PHASE 0
#endif

#define LAS __attribute__((address_space(3)))
#define GAS __attribute__((address_space(1)))
typedef unsigned short bf16_t;
typedef short bf16x8 __attribute__((ext_vector_type(8)));
typedef short s16x4 __attribute__((ext_vector_type(4)));
typedef float f32x4 __attribute__((ext_vector_type(4)));
typedef float f32x2 __attribute__((ext_vector_type(2)));
typedef float f32x16 __attribute__((ext_vector_type(16)));
typedef unsigned u32x4 __attribute__((ext_vector_type(4)));
typedef unsigned u32x2 __attribute__((ext_vector_type(2)));

constexpr int DM = 4096, SEQ = 2048, NB = 4, M = NB * SEQ, DI = 8192, DMEMB = 2048, DMIX = 6144, MEMLEN = 256, MHD = 512, PGRP = 1536, NHEAD = 24;
constexpr int N0 = 16384, N1 = 28672, MROWS = NB * MEMLEN;
constexpr int PADE = 128, LD4 = DM + PADE, LD8 = DI + PADE, LD6 = DMIX + PADE, LD2 = DMEMB + PADE, LDP = PGRP + PADE;
constexpr int NCT6 = DMIX / 256, NCT2 = DMEMB / 256, NCT8 = DI / 256;
__device__ __forceinline__ size_t blk(int row, int col, int nct) { return ((size_t)((row >> 8) * nct + (col >> 8)) << 16) + (size_t)(((row & 255) << 8) + (col & 255)); }
constexpr float RMS_EPS = 1e-6f, SUBLN_EPS = 1e-5f;
constexpr float LOG2E = 1.4426950408889634f;

__device__ __forceinline__ unsigned cvt_pk_bf16(float lo, float hi) { unsigned r; asm volatile("v_cvt_pk_bf16_f32 %0, %1, %2" : "=v"(r) : "v"(lo), "v"(hi)); return r; }
__device__ __forceinline__ float bf_lo(unsigned w) { return __uint_as_float(w << 16); }
__device__ __forceinline__ float bf_hi(unsigned w) { return __uint_as_float(w & 0xffff0000u); }
__device__ __forceinline__ float silu_f(float v) { return v * __builtin_amdgcn_rcpf(1.0f + __builtin_amdgcn_exp2f(-LOG2E * v)); }

namespace pg8 {
constexpr int BM = 256, BK = 64, HALF = 128, HTB = HALF * BK * 2, STAGE_BYTES = 8 * HTB, NXCD = 8, WGM = 8;
__host__ __device__ __forceinline__ int lds_byte(int r, int c) { const int st = (r >> 4) * 2 + (c >> 5), rr = r & 15, cc = c & 31, ob = rr * 64 + cc * 2; return st * 1024 + (ob ^ (((ob >> 9) & 1) << 5)); }
__host__ __device__ __forceinline__ void stage_rc(int b, int& R, int& C) { const int st = b / 1024, sb = b % 1024, swz = sb ^ (((sb >> 9) & 1) << 5); R = (st >> 1) * 16 + swz / 64; C = (st & 1) * 32 + (swz % 64) / 2; }
__host__ __device__ __forceinline__ int perm32(int rho) { const int n = rho >> 4, i = rho & 15; return 8 * (i >> 2) + 4 * n + (i & 3); }

struct Unit { int pm, pn, g; };
struct Gemm { const bf16_t* A; const bf16_t* Bt; int lda, ldb, K; size_t gsA, gsB; int ablk = 0, bblk = 0; };

__device__ __forceinline__ void tile_map(int wgid, int nM, int nN, int& pm, int& pn) {
    const int nwg = nM * nN;
    { const int q = nwg / NXCD, r = nwg % NXCD, xcd = wgid % NXCD, off = wgid / NXCD; wgid = (xcd < r ? xcd * (q + 1) : r * (q + 1) + (xcd - r) * q) + off; }
    const int nig = WGM * nN, gid = wgid / nig, fm = gid * WGM, gsz = (nM - fm) < WGM ? (nM - fm) : WGM;
    pm = fm + ((wgid % nig) % gsz); pn = (wgid % nig) / gsz;
}
struct Sched {
    int nM, nN, per, total, G, c;
    __device__ void init(int nM_, int nN_, int ngroups, int G_, int c_) { nM = nM_; nN = nN_; per = nM_ * nN_; total = per * ngroups; G = G_; c = c_; }
    __device__ __forceinline__ bool next(int i, Unit& u) const {
        const int L = i * G + c; if (L >= total || c >= G) return false;
        u.g = L / per; tile_map(L % per, nM, nN, u.pm, u.pn); return true;
    }
};

__device__ __forceinline__ void store8(bf16_t* p, f32x4 v0, f32x4 v1) {
    u32x4 w; w.x = cvt_pk_bf16(v0[0], v0[1]); w.y = cvt_pk_bf16(v0[2], v0[3]); w.z = cvt_pk_bf16(v1[0], v1[1]); w.w = cvt_pk_bf16(v1[2], v1[3]);
#if EPI_NT
    __builtin_nontemporal_store(w, (u32x4*)p);
#else
    *(u32x4*)p = w;
#endif
}
struct EpiProj {
    static constexpr bool PERM = true;
    bf16_t *b0, *b1, *b2, *b3, *b4; int e0, e1, e2, e3;
    const float* rowss;
    __device__ __forceinline__ void pre(const Unit& u, int wr, int fr, float (&rq)[2][4]) const {
#pragma unroll
        for (int ai = 0; ai < 2; ++ai)
#pragma unroll
            for (int m = 0; m < 4; ++m) rq[ai][m] = rowss ? __hip_atomic_load(rowss + u.pm * BM + wr * 64 + fr + ai * HALF + m * 16, __ATOMIC_RELAXED, __HIP_MEMORY_SCOPE_AGENT) : 0.f;
    }
    __device__ __forceinline__ void operator()(const f32x4 (&acc)[2][2][4][2], const Unit& u, int wr, int wc, int fr, int fq, const float (&rq)[2][4]) const {
        const int pn = u.pn; bf16_t* base; int nct, ct; bool act = false;
        if (pn < e0) { base = b0; nct = NCT6; ct = pn; }
        else if (pn < e1) { base = b1; nct = NCT6; ct = pn - e0; }
        else if (pn < e2) { base = b2; nct = NCT6; ct = pn - e1; }
        else if (pn < e3) { base = b3; nct = NCT2; ct = pn - e2; }
        else { base = b4; nct = NCT8; ct = pn - e3; act = true; }
        bf16_t* tile = base + ((size_t)(u.pm * nct + ct) << 16) + (wr * 64 + fr) * 256 + wc * 32 + 8 * fq;
        float rs[2][4];
#pragma unroll
        for (int ai = 0; ai < 2; ++ai)
#pragma unroll
            for (int m = 0; m < 4; ++m) rs[ai][m] = rowss ? __builtin_amdgcn_rsqf(rq[ai][m] * (1.0f / DM) + RMS_EPS) : 1.0f;
#pragma unroll
        for (int ai = 0; ai < 2; ++ai)
#pragma unroll
            for (int m = 0; m < 4; ++m) { bf16_t* rowp = tile + (ai * HALF + m * 16) * 256;
#pragma unroll
                for (int bj = 0; bj < 2; ++bj) { f32x4 v0 = acc[ai][bj][m][0] * rs[ai][m], v1 = acc[ai][bj][m][1] * rs[ai][m];
                    if (act) {
#pragma unroll
                        for (int j = 0; j < 4; ++j) { v0[j] = silu_f(v0[j]); v1[j] = silu_f(v1[j]); } }
                    store8(rowp + bj * HALF, v0, v1); } }
    }
};
struct EpiKV {
    static constexpr bool PERM = true;
    bf16_t *o0, *o1;
    __device__ __forceinline__ void pre(const Unit&, int, int, float (&)[2][4]) const {}
    __device__ __forceinline__ void operator()(const f32x4 (&acc)[2][2][4][2], const Unit& u, int wr, int wc, int fr, int fq, const float (&)[2][4]) const {
        bf16_t* base = u.g ? o1 : o0; const int row0 = u.pm * BM + wr * 64 + fr, col0 = u.pn * BM + wc * 32 + 8 * fq;
#pragma unroll
        for (int ai = 0; ai < 2; ++ai)
#pragma unroll
            for (int m = 0; m < 4; ++m) { bf16_t* rowp = base + (size_t)(row0 + ai * HALF + m * 16) * LD4 + col0;
#pragma unroll
                for (int bj = 0; bj < 2; ++bj) store8(rowp + bj * HALF, acc[ai][bj][m][0], acc[ai][bj][m][1]); }
    }
};
struct EpiPool {
    static constexpr bool PERM = true;
    const bf16_t* sz; bf16_t* yg; const float* scale;
    __device__ __forceinline__ void pre(const Unit&, int, int, float (&)[2][4]) const {}
    __device__ __forceinline__ void operator()(const f32x4 (&acc)[2][2][4][2], const Unit& u, int wr, int wc, int fr, int fq, const float (&)[2][4]) const {
        const int col0 = u.g * PGRP + u.pn * BM + wc * 32 + 8 * fq;
        const size_t t0 = ((size_t)(u.pm * NCT8 + u.g * (PGRP / 256) + u.pn) << 16) + (wr * 64 + fr) * 256 + wc * 32 + 8 * fq;
        f32x4 sc[2][2];
#pragma unroll
        for (int bj = 0; bj < 2; ++bj) { sc[bj][0] = *(const f32x4*)(scale + col0 + bj * HALF); sc[bj][1] = *(const f32x4*)(scale + col0 + bj * HALF + 4); }
        u32x4 zv[2][4][2];
#pragma unroll
        for (int ai = 0; ai < 2; ++ai)
#pragma unroll
            for (int m = 0; m < 4; ++m)
#pragma unroll
                for (int bj = 0; bj < 2; ++bj) zv[ai][m][bj] = *(const u32x4*)(sz + t0 + (ai * HALF + m * 16) * 256 + bj * HALF);
#pragma unroll
        for (int ai = 0; ai < 2; ++ai) {
#pragma unroll
            for (int m = 0; m < 4; ++m) { bf16_t* rowp = yg + t0 + (ai * HALF + m * 16) * 256;
#pragma unroll
                for (int bj = 0; bj < 2; ++bj) { const u32x4 z = zv[ai][m][bj];
                    f32x4 v0 = acc[ai][bj][m][0] * sc[bj][0], v1 = acc[ai][bj][m][1] * sc[bj][1];
                    v0[0] *= bf_lo(z.x); v0[1] *= bf_hi(z.x); v0[2] *= bf_lo(z.y); v0[3] *= bf_hi(z.y);
                    v1[0] *= bf_lo(z.z); v1[1] *= bf_hi(z.z); v1[2] *= bf_lo(z.w); v1[3] *= bf_hi(z.w);
                    store8(rowp + bj * HALF, v0, v1); } } }
    }
};
template <bool RESBF> struct EpiResid {
    static constexpr bool PERM = true;
    const void* res; bf16_t* outb; float* rowss;
    __device__ __forceinline__ void pre(const Unit&, int, int, float (&)[2][4]) const {}
    __device__ __forceinline__ void operator()(const f32x4 (&acc)[2][2][4][2], const Unit& u, int wr, int wc, int fr, int fq, const float (&)[2][4]) const {
        const int row0 = u.pm * BM + wr * 64 + fr, col0 = u.pn * BM + wc * 32 + 8 * fq;
        u32x4 rw[2][4][2];
        if constexpr (RESBF) {
#pragma unroll
            for (int ai = 0; ai < 2; ++ai)
#pragma unroll
                for (int m = 0; m < 4; ++m)
#pragma unroll
                    for (int bj = 0; bj < 2; ++bj) rw[ai][m][bj] = *(const u32x4*)((const bf16_t*)res + (size_t)(row0 + ai * HALF + m * 16) * LD4 + col0 + bj * HALF);
        }
#pragma unroll
        for (int ai = 0; ai < 2; ++ai) {
            f32x4 rv[4][2][2];
#pragma unroll
            for (int m = 0; m < 4; ++m)
#pragma unroll
                for (int bj = 0; bj < 2; ++bj) { const int row = row0 + ai * HALF + m * 16, col = col0 + bj * HALF;
                    if constexpr (RESBF) { const u32x4 w = rw[ai][m][bj];
                        rv[m][bj][0] = (f32x4){bf_lo(w.x), bf_hi(w.x), bf_lo(w.y), bf_hi(w.y)}; rv[m][bj][1] = (f32x4){bf_lo(w.z), bf_hi(w.z), bf_lo(w.w), bf_hi(w.w)}; }
                    else { const float* rp = (const float*)res + (size_t)row * DM + col; rv[m][bj][0] = *(const f32x4*)rp; rv[m][bj][1] = *(const f32x4*)(rp + 4); } }
#pragma unroll
            for (int m = 0; m < 4; ++m) { const int row = row0 + ai * HALF + m * 16; float ssq = 0.f;
#pragma unroll
                for (int bj = 0; bj < 2; ++bj) { const f32x4 v0 = rv[m][bj][0] + acc[ai][bj][m][0], v1 = rv[m][bj][1] + acc[ai][bj][m][1];
                    ssq += (v0[0] * v0[0] + v0[1] * v0[1]) + (v0[2] * v0[2] + v0[3] * v0[3]) + (v1[0] * v1[0] + v1[1] * v1[1]) + (v1[2] * v1[2] + v1[3] * v1[3]);
                    store8(outb + (size_t)row * LD4 + col0 + bj * HALF, v0, v1); }
                ssq += __shfl_xor(ssq, 16); ssq += __shfl_xor(ssq, 32);
                if (fq == 0) (void)__hip_atomic_fetch_add(rowss + row, ssq, __ATOMIC_RELAXED, __HIP_MEMORY_SCOPE_AGENT); } }
    }
};
template <class Epi>
__device__ __forceinline__ void gemm_phase(LAS unsigned char* lds, const Gemm g, const Sched& S, const Epi& E) {
    const int tid = threadIdx.x, wid = __builtin_amdgcn_readfirstlane(tid >> 6), lane = tid & 63, wr = wid >> 2, wc = wid & 3, fr = lane & 15, fq = lane >> 4;
    const int nt = g.K / BK;
    unsigned voffA[2], voffB[2];
#pragma unroll
    for (int i = 0; i < 2; ++i) { int R, C; stage_rc(tid * 16 + i * 8192, R, C); const int Rb = Epi::PERM ? ((R & ~31) + perm32(R & 31)) : R;
        voffA[i] = (unsigned)(R * g.lda + C) * 2u; voffB[i] = (unsigned)(Rb * g.ldb + C) * 2u; }
    const size_t kstep = (size_t)(BK * 2);
    const size_t hA = (size_t)HALF * g.lda * 2, hB = (size_t)HALF * g.ldb * 2, tA = g.ablk ? ((size_t)(g.K >> 8) << 17) : 2 * hA, tB = g.bblk ? ((size_t)(g.K >> 8) << 17) : 2 * hB;
#define KOA(t_) (g.ablk ? (((size_t)((t_) >> 2) << 17) + (size_t)((t_) & 3) * 128) : (size_t)(t_) * kstep)
#define KOB(t_) (g.bblk ? (((size_t)((t_) >> 2) << 17) + (size_t)((t_) & 3) * 128) : (size_t)(t_) * kstep)
    const unsigned ldsw = (unsigned)wid * 1024u;
    const int aoff = lds_byte(wr * 64 + fr, fq * 8), boff = lds_byte(wc * 32 + fr, fq * 8);
#define PG8_SA(b, h) (((b) * 2 + (h)) * HTB)
#define PG8_SB(b, h) ((4 + (b) * 2 + (h)) * HTB)
#define PG8_STAGE(bufoff, gbase, voff) do { _Pragma("unroll") for (int _i = 0; _i < 2; ++_i) \
        __builtin_amdgcn_global_load_lds((const unsigned*)((const char*)(gbase) + (voff)[_i]), (LAS unsigned*)(lds + (bufoff) + ldsw + _i * 8192), 16, 0, 0); } while (0)
#define PG8_LDA(dst, b, h) do { _Pragma("unroll") for (int m = 0; m < 4; ++m) _Pragma("unroll") for (int k = 0; k < 2; ++k) dst[m][k] = *(const LAS bf16x8*)(lds + PG8_SA(b, h) + aoff + m * 2048 + k * 1024); } while (0)
#define PG8_LDB(dst, b, h) do { _Pragma("unroll") for (int n = 0; n < 2; ++n) _Pragma("unroll") for (int k = 0; k < 2; ++k) dst[n][k] = *(const LAS bf16x8*)(lds + PG8_SB(b, h) + boff + n * 2048 + k * 1024); } while (0)
#define PG8_MMA(ai, bj, At, Bt) do { __builtin_amdgcn_s_setprio(1); _Pragma("unroll") for (int m = 0; m < 4; ++m) _Pragma("unroll") for (int n = 0; n < 2; ++n) _Pragma("unroll") for (int k = 0; k < 2; ++k) \
        acc[ai][bj][m][n] = __builtin_amdgcn_mfma_f32_16x16x32_bf16(Bt[n][k], At[m][k], acc[ai][bj][m][n], 0, 0, 0); __builtin_amdgcn_s_setprio(0); } while (0)
#define PG8_WAIT_V(n) asm volatile("s_waitcnt vmcnt(" #n ")" ::: "memory")
#define PG8_WAIT_L(n) asm volatile("s_waitcnt lgkmcnt(" #n ")" ::: "memory")
#define PG8_BAR __builtin_amdgcn_s_barrier()
#define PG8_SCHED __builtin_amdgcn_sched_barrier(0)
    Unit cur, nxt; int ui = 0;
    if (!S.next(0, cur)) return;
    f32x4 acc[2][2][4][2];
#pragma unroll
    for (int a = 0; a < 2; ++a)
#pragma unroll
        for (int b = 0; b < 2; ++b)
#pragma unroll
            for (int m = 0; m < 4; ++m)
#pragma unroll
                for (int n = 0; n < 2; ++n) acc[a][b][m][n] = (f32x4){0.f, 0.f, 0.f, 0.f};
    float rq[2][4]; E.pre(cur, wr, fr, rq);
    bf16x8 At[4][2], B0[2][2], B1[2][2];
    const char* cA = (const char*)g.A + (size_t)cur.g * g.gsA + (size_t)cur.pm * tA; const char* cB = (const char*)g.Bt + (size_t)cur.g * g.gsB + (size_t)cur.pn * tB;
#if PG8_SP2
    PG8_STAGE(PG8_SB(0, 0), cB, voffB); PG8_STAGE(PG8_SB(0, 1), cB + hB, voffB); PG8_STAGE(PG8_SA(0, 0), cA, voffA); PG8_STAGE(PG8_SA(0, 1), cA + hA, voffA);
    if (wr == 1) PG8_BAR;
    PG8_WAIT_V(2); PG8_BAR;
    PG8_STAGE(PG8_SB(1, 0), cB + KOB(1), voffB); PG8_STAGE(PG8_SA(1, 0), cA + KOA(1), voffA); PG8_STAGE(PG8_SB(1, 1), cB + hB + KOB(1), voffB);
    PG8_WAIT_V(6); PG8_BAR;
#else
    PG8_STAGE(PG8_SB(0, 0), cB, voffB); PG8_STAGE(PG8_SA(0, 0), cA, voffA); PG8_STAGE(PG8_SB(0, 1), cB + hB, voffB); PG8_STAGE(PG8_SA(0, 1), cA + hA, voffA);
    if (wr == 1) PG8_BAR;
    PG8_WAIT_V(4); PG8_BAR;
    PG8_STAGE(PG8_SB(1, 0), cB + KOB(1), voffB); PG8_STAGE(PG8_SA(1, 0), cA + KOA(1), voffA); PG8_STAGE(PG8_SB(1, 1), cB + hB + KOB(1), voffB);
    PG8_WAIT_V(6); PG8_BAR;
#endif
    for (;;) {
        const bool has_next = S.next(ui + 1, nxt);
        const char* nA = has_next ? (const char*)g.A + (size_t)nxt.g * g.gsA + (size_t)nxt.pm * tA : cA; const char* nB = has_next ? (const char*)g.Bt + (size_t)nxt.g * g.gsB + (size_t)nxt.pn * tB : cB;
        for (int t = 0; t < nt; t += 2) {
            const bool last = (t == nt - 2);
            const char* a1 = cA + KOA(t + 1);
            const char* a2 = last ? nA : cA + KOA(t + 2); const char* b2 = last ? nB : cB + KOB(t + 2);
            const char* a3 = last ? nA + KOA(1) : cA + KOA(t + 3); const char* b3 = last ? nB + KOB(1) : cB + KOB(t + 3);
#if PG8_SP2
            PG8_LDB(B0, 0, 0); PG8_LDB(B1, 0, 1); PG8_SCHED; PG8_LDA(At, 0, 0); PG8_STAGE(PG8_SA(1, 1), a1 + hA, voffA);
            PG8_WAIT_V(8); PG8_WAIT_L(0); PG8_BAR; PG8_MMA(0, 0, At, B0); PG8_MMA(0, 1, At, B1); PG8_BAR; PG8_SCHED;
            PG8_LDA(At, 0, 1); PG8_STAGE(PG8_SB(0, 0), b2, voffB); PG8_STAGE(PG8_SB(0, 1), b2 + hB, voffB); PG8_STAGE(PG8_SA(0, 0), a2, voffA);
            PG8_WAIT_V(8); PG8_WAIT_L(0); PG8_BAR; PG8_MMA(1, 0, At, B0); PG8_MMA(1, 1, At, B1); PG8_BAR; PG8_SCHED;
            PG8_LDB(B0, 1, 0); PG8_LDB(B1, 1, 1); PG8_SCHED; PG8_LDA(At, 1, 0); PG8_STAGE(PG8_SA(0, 1), a2 + hA, voffA);
            PG8_WAIT_V(8); PG8_WAIT_L(0); PG8_BAR; PG8_MMA(0, 0, At, B0); PG8_MMA(0, 1, At, B1); PG8_BAR; PG8_SCHED;
            PG8_LDA(At, 1, 1); PG8_STAGE(PG8_SB(1, 0), b3, voffB); PG8_STAGE(PG8_SB(1, 1), b3 + hB, voffB); PG8_STAGE(PG8_SA(1, 0), a3, voffA);
            PG8_WAIT_V(8); PG8_WAIT_L(0); PG8_BAR; PG8_MMA(1, 0, At, B0); PG8_MMA(1, 1, At, B1); PG8_BAR; PG8_SCHED;
        #else
            PG8_LDB(B0, 0, 0); PG8_SCHED; PG8_LDA(At, 0, 0); PG8_STAGE(PG8_SA(1, 1), a1 + hA, voffA);
            PG8_WAIT_L(8); PG8_BAR; PG8_WAIT_L(0); PG8_MMA(0, 0, At, B0); PG8_BAR; PG8_SCHED;
            PG8_LDB(B1, 0, 1); PG8_STAGE(PG8_SB(0, 0), b2, voffB);
            PG8_BAR; PG8_WAIT_L(0); PG8_MMA(0, 1, At, B1); PG8_BAR;
            PG8_LDA(At, 0, 1); PG8_STAGE(PG8_SA(0, 0), a2, voffA);
            PG8_BAR; PG8_WAIT_L(0); PG8_MMA(1, 0, At, B0); PG8_BAR; PG8_SCHED;
            PG8_STAGE(PG8_SB(0, 1), b2 + hB, voffB);
            PG8_WAIT_V(6); PG8_BAR; PG8_MMA(1, 1, At, B1); PG8_BAR;
            PG8_LDB(B0, 1, 0); PG8_SCHED; PG8_LDA(At, 1, 0); PG8_STAGE(PG8_SA(0, 1), a2 + hA, voffA);
            PG8_WAIT_L(8); PG8_BAR; PG8_WAIT_L(0); PG8_MMA(0, 0, At, B0); PG8_BAR; PG8_SCHED;
            PG8_LDB(B1, 1, 1); PG8_STAGE(PG8_SB(1, 0), b3, voffB);
            PG8_BAR; PG8_WAIT_L(0); PG8_MMA(0, 1, At, B1); PG8_BAR;
            PG8_LDA(At, 1, 1); PG8_STAGE(PG8_SA(1, 0), a3, voffA);
            PG8_BAR; PG8_WAIT_L(0); PG8_MMA(1, 0, At, B0); PG8_BAR; PG8_SCHED;
            PG8_STAGE(PG8_SB(1, 1), b3 + hB, voffB);
            PG8_WAIT_V(6); PG8_BAR; PG8_MMA(1, 1, At, B1); PG8_BAR;
#endif
        }
        if (wr == 0) PG8_BAR;
        E(acc, cur, wr, wc, fr, fq, rq);
        if (!has_next) break;
#pragma unroll
        for (int a = 0; a < 2; ++a)
#pragma unroll
            for (int b = 0; b < 2; ++b)
#pragma unroll
                for (int m = 0; m < 4; ++m)
#pragma unroll
                    for (int n = 0; n < 2; ++n) acc[a][b][m][n] = (f32x4){0.f, 0.f, 0.f, 0.f};
        cur = nxt; cA = nA; cB = nB; ++ui;
        E.pre(cur, wr, fr, rq);
        if (wr == 1) PG8_BAR;
    }
    PG8_WAIT_V(0);
    PG8_BAR;
#undef KOA
#undef KOB
#undef PG8_SA
#undef PG8_SB
#undef PG8_STAGE
#undef PG8_LDA
#undef PG8_LDB
#undef PG8_MMA
#undef PG8_WAIT_V
#undef PG8_WAIT_L
#undef PG8_BAR
#undef PG8_SCHED
}
}

namespace att {
#define KSWZ(row, colB) ((row) * 256 + ((colB) ^ (((row) & 15) << 4)))
#define SBAR() __builtin_amdgcn_sched_barrier(0)
__device__ __forceinline__ int crow(int r, int hi) { return (r & 3) + 8 * (r >> 2) + 4 * hi; }
__device__ __forceinline__ unsigned dma_k_off(int i, int ld, int wid, int lane) { const int chunk = (i * 8 + wid) * 64 + lane, row = chunk >> 4, cg = (chunk & 15) ^ (row & 15); return (unsigned)(row * ld + cg * 8) * 2u; }
__device__ __forceinline__ void glds16(const void* sbase, unsigned voff, unsigned lds_dst) {
    unsigned keep;
    asm volatile("s_mov_b32 %0, m0\n\ts_mov_b32 m0, %3\n\ts_nop 0\n\tglobal_load_lds_dwordx4 %1, %2\n\ts_mov_b32 m0, %0" : "=&s"(keep) : "v"(voff), "s"(sbase), "s"(lds_dst) : "memory");
}
__device__ __forceinline__ void glds_tile(const void* k0b, const void* k1b, const void* vb, unsigned k0o, unsigned k1o, unsigned v0, unsigned v1, unsigned v2, unsigned v3, unsigned lds_dst) {
    unsigned keep;
    asm volatile("s_mov_b32 %0, m0\n\t"
                 "s_mov_b32 m0, %10\n\ts_nop 0\n\tglobal_load_lds_dwordx4 %1, %7\n\t"
                 "s_add_u32 m0, m0, 0x2000\n\ts_nop 0\n\tglobal_load_lds_dwordx4 %2, %7\n\t"
                 "s_add_u32 m0, m0, 0x2000\n\ts_nop 0\n\tglobal_load_lds_dwordx4 %1, %8\n\t"
                 "s_add_u32 m0, m0, 0x2000\n\ts_nop 0\n\tglobal_load_lds_dwordx4 %2, %8\n\t"
                 "s_add_u32 m0, m0, 0x2000\n\ts_nop 0\n\tglobal_load_lds_dwordx4 %3, %9\n\t"
                 "s_add_u32 m0, m0, 0x2000\n\ts_nop 0\n\tglobal_load_lds_dwordx4 %4, %9\n\t"
                 "s_add_u32 m0, m0, 0x2000\n\ts_nop 0\n\tglobal_load_lds_dwordx4 %5, %9\n\t"
                 "s_add_u32 m0, m0, 0x2000\n\ts_nop 0\n\tglobal_load_lds_dwordx4 %6, %9\n\t"
                 "s_mov_b32 m0, %0"
                 : "=&s"(keep) : "v"(k0o), "v"(k1o), "v"(v0), "v"(v1), "v"(v2), "v"(v3), "s"(k0b), "s"(k1b), "s"(vb), "s"(lds_dst) : "memory", "scc");
}
__device__ __forceinline__ void dma_k(LAS unsigned char* lds, unsigned dst, const bf16_t* src, unsigned off0, unsigned off1, int wid) {
    const unsigned l0 = (unsigned)(uintptr_t)lds + dst + (unsigned)wid * 1024u;
    glds16(src, off0, l0); glds16(src, off1, l0 + 8192u);
}
__device__ __forceinline__ unsigned dma_v_off(int i, int ld, int wid, int lane) {
    const int o = ((i * 8 + wid) * 64 + lane) * 16, sub = o >> 9, kk = (sub >> 3) * 8 + ((o & 511) >> 6), col = (sub & 7) * 32 + ((o & 63) >> 1);
    const int key = (kk & ~0xC) | ((kk & 4) << 1) | ((kk & 8) >> 1); return (unsigned)(key * ld + col) * 2u;
}
__device__ __forceinline__ void dma_v(LAS unsigned char* lds, unsigned dst, const bf16_t* src, const unsigned (&off)[4], int wid) {
    const unsigned l0 = (unsigned)(uintptr_t)lds + dst + (unsigned)wid * 1024u;
#pragma unroll
    for (int i = 0; i < 4; ++i) glds16(src, off[i], l0 + (unsigned)i * 8192u);
}
__device__ __forceinline__ int v_rd_base(int lane) { return ((lane & 3) << 3) | (((lane >> 2) & 3) << 6) | (((lane >> 4) & 1) << 5) | (((lane >> 5) & 1) << 8); }
constexpr int v_rd_off(int d0, int ks, int half) { return d0 * 512 + ks * 8192 + half * 4096; }
template <int OFF> __device__ __forceinline__ s16x4 tr_read(int vb) {
    s16x4 r; asm volatile("ds_read_b64_tr_b16 %0, %1 offset:%2" : "=&v"(r) : "v"(vb), "i"(OFF) : "memory"); return r;
}
template <int D0> __device__ __forceinline__ void pv_one(f32x16& od, int vb, bf16x8 pa0, bf16x8 pa1, bf16x8 pa2, bf16x8 pa3) {
    const s16x4 l0 = tr_read<v_rd_off(D0, 0, 0)>(vb), h0 = tr_read<v_rd_off(D0, 0, 1)>(vb), l1 = tr_read<v_rd_off(D0, 1, 0)>(vb), h1 = tr_read<v_rd_off(D0, 1, 1)>(vb);
    const s16x4 l2 = tr_read<v_rd_off(D0, 2, 0)>(vb), h2 = tr_read<v_rd_off(D0, 2, 1)>(vb), l3 = tr_read<v_rd_off(D0, 3, 0)>(vb), h3 = tr_read<v_rd_off(D0, 3, 1)>(vb);
    asm volatile("s_waitcnt lgkmcnt(0)" ::: "memory"); SBAR();
#define PK(L, H) (bf16x8){L[0], L[1], L[2], L[3], H[0], H[1], H[2], H[3]}
    od = __builtin_amdgcn_mfma_f32_32x32x16_bf16(pa0, PK(l0, h0), od, 0, 0, 0);
    od = __builtin_amdgcn_mfma_f32_32x32x16_bf16(pa1, PK(l1, h1), od, 0, 0, 0);
    od = __builtin_amdgcn_mfma_f32_32x32x16_bf16(pa2, PK(l2, h2), od, 0, 0, 0);
    od = __builtin_amdgcn_mfma_f32_32x32x16_bf16(pa3, PK(l3, h3), od, 0, 0, 0);
#undef PK
}
__device__ __forceinline__ void pv_all(f32x16 (&o)[8], int vb, bf16x8 pa0, bf16x8 pa1, bf16x8 pa2, bf16x8 pa3) {
    pv_one<0>(o[0], vb, pa0, pa1, pa2, pa3); pv_one<1>(o[1], vb, pa0, pa1, pa2, pa3); pv_one<2>(o[2], vb, pa0, pa1, pa2, pa3); pv_one<3>(o[3], vb, pa0, pa1, pa2, pa3);
    pv_one<4>(o[4], vb, pa0, pa1, pa2, pa3); pv_one<5>(o[5], vb, pa0, pa1, pa2, pa3); pv_one<6>(o[6], vb, pa0, pa1, pa2, pa3); pv_one<7>(o[7], vb, pa0, pa1, pa2, pa3);
}
__device__ __forceinline__ void qkt_acc(f32x16& p0, f32x16& p1, const LAS unsigned char* Ks, const bf16x8 (&qr)[8], int r32, int hi) {
#pragma unroll
    for (int d0 = 0; d0 < 8; ++d0) { const int cb = (d0 * 16 + hi * 8) * 2;
        const bf16x8 b0 = *(const LAS bf16x8*)(Ks + KSWZ(r32, cb));
        const bf16x8 b1 = *(const LAS bf16x8*)(Ks + KSWZ(32 + r32, cb));
        p0 = __builtin_amdgcn_mfma_f32_32x32x16_bf16(b0, qr[d0], p0, 0, 0, 0);
        p1 = __builtin_amdgcn_mfma_f32_32x32x16_bf16(b1, qr[d0], p1, 0, 0, 0); }
}
#define PK4(P, BASE, OUT) do { unsigned a0 = cvt_pk_bf16(P[BASE + 0], P[BASE + 1]), a1 = cvt_pk_bf16(P[BASE + 2], P[BASE + 3]);   \
    unsigned b0 = cvt_pk_bf16(P[BASE + 4], P[BASE + 5]), b1 = cvt_pk_bf16(P[BASE + 6], P[BASE + 7]);                              \
    auto r0 = __builtin_amdgcn_permlane32_swap(a0, b0, false, false); auto r1 = __builtin_amdgcn_permlane32_swap(a1, b1, false, false); \
    u32x4 w = {r0[0], r1[0], r0[1], r1[1]}; OUT = *reinterpret_cast<bf16x8*>(&w); } while (0)
__device__ __forceinline__ float half_max(float v) { auto rr = __builtin_amdgcn_permlane32_swap(__float_as_uint(v), __float_as_uint(v), false, false); return fmaxf(__uint_as_float(rr[0]), __uint_as_float(rr[1])); }
__device__ __forceinline__ float half_sum(float v) { auto rr = __builtin_amdgcn_permlane32_swap(__float_as_uint(v), __float_as_uint(v), false, false); return __uint_as_float(rr[0]) + __uint_as_float(rr[1]); }

struct VFrag { s16x4 l0, h0, l1, h1; };
template <int D0, int HALF> __device__ __forceinline__ void v_issue(VFrag& f, int vb) {
    f.l0 = tr_read<v_rd_off(D0, 2 * HALF, 0)>(vb); f.h0 = tr_read<v_rd_off(D0, 2 * HALF, 1)>(vb); f.l1 = tr_read<v_rd_off(D0, 2 * HALF + 1, 0)>(vb); f.h1 = tr_read<v_rd_off(D0, 2 * HALF + 1, 1)>(vb);
}
#define PKV(L, H) (bf16x8){L[0], L[1], L[2], L[3], H[0], H[1], H[2], H[3]}
template <int D0, int HALF> __device__ __forceinline__ void pv_step(f32x16 (&o)[8], VFrag& cur, VFrag& nxt, int vb, bf16x8 pa0, bf16x8 pa1) {
    if constexpr (D0 < 7) { v_issue<D0 + 1, HALF>(nxt, vb); asm volatile("s_waitcnt lgkmcnt(4)" ::: "memory"); }
    else asm volatile("s_waitcnt lgkmcnt(0)" ::: "memory");
    SBAR();
    o[D0] = __builtin_amdgcn_mfma_f32_32x32x16_bf16(pa0, PKV(cur.l0, cur.h0), o[D0], 0, 0, 0);
    o[D0] = __builtin_amdgcn_mfma_f32_32x32x16_bf16(pa1, PKV(cur.l1, cur.h1), o[D0], 0, 0, 0);
    SBAR();
}
template <int HALF> __device__ __forceinline__ void pv_half(f32x16 (&o)[8], VFrag& f0, int vb, bf16x8 pa0, bf16x8 pa1) {
    VFrag f1;
    pv_step<0, HALF>(o, f0, f1, vb, pa0, pa1); pv_step<1, HALF>(o, f1, f0, vb, pa0, pa1); pv_step<2, HALF>(o, f0, f1, vb, pa0, pa1); pv_step<3, HALF>(o, f1, f0, vb, pa0, pa1);
    pv_step<4, HALF>(o, f0, f1, vb, pa0, pa1); pv_step<5, HALF>(o, f1, f0, vb, pa0, pa1); pv_step<6, HALF>(o, f0, f1, vb, pa0, pa1); pv_step<7, HALF>(o, f1, f0, vb, pa0, pa1);
}
struct DiffArgs { const bf16_t* Q; const bf16_t* K; const bf16_t* V; const bf16_t* SZ; bf16_t* YG; const float* subln_g; float lam, lam_scale; };
__device__ __forceinline__ void diff_tile(f32x16 (&o)[8], const LAS unsigned char* Ks, int vb, const bf16x8 (&qr)[8], LAS float* wsc,
                                          float& m_reg, float& l_reg, float slC, float C, int lim0  , bool diag, int r32, int hi) {
    f32x16 p0 = (f32x16){}, p1 = (f32x16){};
    {
        bf16x8 ka[2], kb[2];
        ka[0] = *(const LAS bf16x8*)(Ks + KSWZ(r32, (hi * 8) * 2)); kb[0] = *(const LAS bf16x8*)(Ks + KSWZ(32 + r32, (hi * 8) * 2));
#pragma unroll
        for (int d0 = 0; d0 < 8; ++d0) {
            if (d0 < 7) { const int cb = ((d0 + 1) * 16 + hi * 8) * 2;
                ka[(d0 + 1) & 1] = *(const LAS bf16x8*)(Ks + KSWZ(r32, cb)); kb[(d0 + 1) & 1] = *(const LAS bf16x8*)(Ks + KSWZ(32 + r32, cb)); }
            SBAR();
            p0 = __builtin_amdgcn_mfma_f32_32x32x16_bf16(ka[d0 & 1], qr[d0], p0, 0, 0, 0);
            p1 = __builtin_amdgcn_mfma_f32_32x32x16_bf16(kb[d0 & 1], qr[d0], p1, 0, 0, 0);
            SBAR(); }
    }
    VFrag vf0; v_issue<0, 0>(vf0, vb);
    if (diag) {
#pragma unroll
        for (int r = 0; r < 16; ++r) { const int kp = (r & 3) + 8 * (r >> 2); if (kp > lim0) p0[r] = -INFINITY; if (kp + 32 > lim0) p1[r] = -INFINITY; } }
    float pmax = p0[0];
#pragma unroll
    for (int r = 1; r < 16; ++r) pmax = fmaxf(pmax, p0[r]);
#pragma unroll
    for (int r = 0; r < 16; ++r) pmax = fmaxf(pmax, p1[r]);
    pmax = half_max(pmax) * C;
    float alpha = 1.f;
    if (!__all(pmax - m_reg <= 6.0f)) { const float mn = fmaxf(m_reg, pmax); alpha = __builtin_amdgcn_exp2f(m_reg - mn); m_reg = mn; }
    const float kb0 = -fmaf(slC, (float)lim0, m_reg), kb1 = fmaf(slC, 32.0f, kb0);
    float ps0 = 0.f, ps1 = 0.f;
#pragma unroll
    for (int r = 0; r < 16; ++r) { const float kpf = (float)((r & 3) + 8 * (r >> 2));
        p0[r] = __builtin_amdgcn_exp2f(fmaf(p0[r], C, fmaf(kpf, slC, kb0))); ps0 += p0[r];
        p1[r] = __builtin_amdgcn_exp2f(fmaf(p1[r], C, fmaf(kpf, slC, kb1))); ps1 += p1[r]; }
    const float ps = half_sum(ps0 + ps1); l_reg = l_reg * alpha + ps;
    bf16x8 pa0, pa1, pa2, pa3; PK4(p0, 0, pa0); PK4(p0, 8, pa1); PK4(p1, 0, pa2); PK4(p1, 8, pa3);
    if (__any(alpha < 1.f)) { if (hi == 0) wsc[r32] = alpha; asm volatile("s_waitcnt lgkmcnt(0)" ::: "memory");
#pragma unroll
        for (int r = 0; r < 16; ++r) { const float a = wsc[crow(r, hi)];
#pragma unroll
            for (int d = 0; d < 8; ++d) o[d][r] *= a; } }
    SBAR();
    __builtin_amdgcn_s_setprio(1);
    pv_half<0>(o, vf0, vb, pa0, pa1);
    VFrag vf1; v_issue<0, 1>(vf1, vb); SBAR();
    pv_half<1>(o, vf1, vb, pa2, pa3);
    __builtin_amdgcn_s_setprio(0);
}
__device__ __forceinline__ void diff_unit(LAS unsigned char* lds, LAS float* wsc_all, const DiffArgs& A, int b, int h, int qb, int rev, int wid, int lane) {
    asm volatile("" : "+v"(lane));
    LAS float* wsc = wsc_all + wid * 64;
    const int r32 = lane & 31, hi = lane >> 5, map = wid >> 2, w4 = wid & 3;
    const int q0 = qb * 128, wrow0 = q0 + 32 * w4;
    const size_t rowb = (size_t)b * SEQ;
    const float slope = (h < 16) ? __builtin_amdgcn_exp2f(-0.5f * (float)(h + 1)) : __builtin_amdgcn_exp2f(-0.25f * (float)(2 * (h - 16) + 1));
    const float C = 0.08838834764831845f * LOG2E, slC = slope * LOG2E;
    const bf16_t* K0 = A.K + (((size_t)(b * 8) * NCT6 + h) << 16); const bf16_t* Vb = A.V + (((size_t)(b * 8) * NCT6 + h) << 16);
#define TOFF(jt_) ((((size_t)((jt_) >> 2) * NCT6) << 16) + (size_t)(((jt_) & 3) * 64 * 256))
    const unsigned ko0 = dma_k_off(0, 256, wid, lane), ko1 = ko0 + 16384u;
    unsigned vo[4]; vo[0] = dma_v_off(0, 256, wid, lane);
#pragma unroll
    for (int i = 1; i < 4; ++i) vo[i] = vo[0] + (unsigned)i * 8192u;
    const int NT = 2 * qb + 2;
    const int vbase = (int)(unsigned)(uintptr_t)(lds) + v_rd_base(lane);
    { const size_t ro = TOFF(rev ? NT - 1 : 0); glds_tile(K0 + ro, K0 + 128 + ro, Vb + ro, ko0, ko1, vo[0], vo[1], vo[2], vo[3], (unsigned)(uintptr_t)lds + (unsigned)wid * 1024u); }
    bf16x8 qr[8];
    { const bf16_t* Qw = A.Q + blk((int)rowb + wrow0 + r32, h * 256 + map * 128 + hi * 8, NCT6);
#pragma unroll
      for (int d0 = 0; d0 < 8; ++d0) qr[d0] = *(const bf16x8*)(Qw + d0 * 16); }
    asm volatile("" :: "v"(qr[0]), "v"(qr[1]), "v"(qr[2]), "v"(qr[3]), "v"(qr[4]), "v"(qr[5]), "v"(qr[6]), "v"(qr[7]));
    float m_reg = -1e30f, l_reg = 0.f; f32x16 o[8];
#pragma unroll
    for (int d = 0; d < 8; ++d) o[d] = (f32x16){};
    for (int st = 0; st < NT; ++st) {
        const int jt = rev ? NT - 1 - st : st; const unsigned buf = (unsigned)(st & 1) * 65536u;
        asm volatile("s_waitcnt vmcnt(0)" ::: "memory"); __builtin_amdgcn_s_barrier(); asm volatile("" ::: "memory");
        if (st + 1 < NT) { const unsigned nb = 65536u - buf; const size_t ro = TOFF(rev ? jt - 1 : jt + 1);
            int ln = lane; asm volatile("" : "+v"(ln));
            const unsigned k0o = dma_k_off(0, 256, wid, ln), k1o = k0o + 16384u; unsigned v2[4]; v2[0] = dma_v_off(0, 256, wid, ln);
#pragma unroll
            for (int i = 1; i < 4; ++i) v2[i] = v2[0] + (unsigned)i * 8192u;
            glds_tile(K0 + ro, K0 + 128 + ro, Vb + ro, k0o, k1o, v2[0], v2[1], v2[2], v2[3], (unsigned)(uintptr_t)lds + nb + (unsigned)wid * 1024u);
        }
        const LAS unsigned char* Ks = lds + buf + (unsigned)map * 16384u; const int vb = vbase + (int)buf + 32768;
        const int lim0 = wrow0 + r32 - 64 * jt - 4 * hi;
        if (64 * jt <= wrow0 + 31)
            diff_tile(o, Ks, vb, qr, wsc, m_reg, l_reg, slC, C, lim0, 64 * jt + 63 > wrow0, r32, hi);
    }
    if (hi == 0) wsc[32 + r32] = l_reg;
    asm volatile("s_waitcnt lgkmcnt(0)" ::: "memory");
    float rli[16];
#pragma unroll
    for (int r = 0; r < 16; r += 4) { const f32x4 l4 = *(const LAS f32x4*)(wsc + 32 + 8 * (r >> 2) + 4 * hi);
#pragma unroll
        for (int e = 0; e < 4; ++e) rli[r + e] = __builtin_amdgcn_rcpf(l4[e]); }
    asm volatile("s_waitcnt lgkmcnt(0)" ::: "memory"); __builtin_amdgcn_s_barrier(); asm volatile("" ::: "memory");
    LAS f32x4* Xo = (LAS f32x4*)lds + (size_t)(w4 * 2 + map) * 1024 + lane;
    const LAS f32x4* Xi = (const LAS f32x4*)lds + (size_t)(w4 * 2 + (map ^ 1)) * 1024 + lane;
    float v[4][16];
    if (map == 0) {
#pragma unroll
        for (int dd = 0; dd < 4; ++dd)
#pragma unroll
            for (int r = 0; r < 16; r += 4) { Xo[(dd * 4 + (r >> 2)) * 64] = (f32x4){o[4 + dd][r] * rli[r], o[4 + dd][r + 1] * rli[r + 1], o[4 + dd][r + 2] * rli[r + 2], o[4 + dd][r + 3] * rli[r + 3]};
#pragma unroll
                for (int e = 0; e < 4; ++e) v[dd][r + e] = o[dd][r + e] * rli[r + e]; }
    } else {
#pragma unroll
        for (int dd = 0; dd < 4; ++dd)
#pragma unroll
            for (int r = 0; r < 16; r += 4) { Xo[(dd * 4 + (r >> 2)) * 64] = (f32x4){o[dd][r] * rli[r], o[dd][r + 1] * rli[r + 1], o[dd][r + 2] * rli[r + 2], o[dd][r + 3] * rli[r + 3]};
#pragma unroll
                for (int e = 0; e < 4; ++e) v[dd][r + e] = o[4 + dd][r + e] * rli[r + e]; }
    }
    asm volatile("s_waitcnt lgkmcnt(0)" ::: "memory"); __builtin_amdgcn_s_barrier(); asm volatile("" ::: "memory");
    const int cbase = h * 256 + map * 128, c8 = (lane & 15) * 8, rq = lane >> 4;
    u32x4 gz[8]; float gsub[4];
#pragma unroll
    for (int i = 0; i < 8; ++i) gz[i] = *(const u32x4*)(A.SZ + blk((int)rowb + wrow0 + 4 * i + rq, cbase + c8, NCT8));
#pragma unroll
    for (int dd = 0; dd < 4; ++dd) gsub[dd] = A.subln_g[map * 128 + dd * 32 + r32];
    float ss[16];
#pragma unroll
    for (int r = 0; r < 16; ++r) ss[r] = 0.f;
#pragma unroll
    for (int dd = 0; dd < 4; ++dd)
#pragma unroll
        for (int r = 0; r < 16; r += 4) { const f32x4 x4 = Xi[(dd * 4 + (r >> 2)) * 64];
#pragma unroll
            for (int e = 0; e < 4; ++e) { const float x = x4[e]; const float y = map ? (x - A.lam * v[dd][r + e]) : (v[dd][r + e] - A.lam * x); v[dd][r + e] = y; ss[r + e] += y * y; } }
#define ROR_ADD(X, N) X += __builtin_bit_cast(float, __builtin_amdgcn_update_dpp(0, __builtin_bit_cast(int, X), 0x120 | (N), 0xf, 0xf, false))
#pragma unroll
    for (int r = 0; r < 16; ++r) { float sq = ss[r];
        ROR_ADD(sq, 8); ROR_ADD(sq, 4); ROR_ADD(sq, 2); ROR_ADD(sq, 1);
        sq += __shfl_xor(sq, 16);
        ss[r] = sq; }
#undef ROR_ADD
    if (r32 == 0) {
#pragma unroll
        for (int r = 0; r < 16; r += 4) *(LAS f32x4*)(wsc + 32 + hi * 16 + r) = (f32x4){ss[r], ss[r + 1], ss[r + 2], ss[r + 3]}; }
    asm volatile("s_waitcnt lgkmcnt(0)" ::: "memory"); __builtin_amdgcn_s_barrier(); asm volatile("" ::: "memory");
    { const LAS float* pw = wsc_all + (wid ^ 4) * 64 + 32 + hi * 16;
#pragma unroll
      for (int r = 0; r < 16; r += 4) { const f32x4 p4 = *(const LAS f32x4*)(pw + r);
#pragma unroll
          for (int e = 0; e < 4; ++e) ss[r + e] = __builtin_amdgcn_rsqf((ss[r + e] + p4[e]) * (1.0f / 256.0f) + SUBLN_EPS) * A.lam_scale; } }
    LAS float* T = (LAS float*)lds + wid * 4096;
    { LAS float* Te = T + (4 * hi) * 128 + r32 + hi * 32; LAS float* To = T + (4 * hi) * 128 + r32 - hi * 32;
#pragma unroll
      for (int dd = 0; dd < 4; ++dd)
#pragma unroll
          for (int r = 0; r < 16; ++r) ((dd & 1) ? To : Te)[((r & 3) + 8 * (r >> 2)) * 128 + dd * 32] = v[dd][r] * ss[r] * gsub[dd]; }
    asm volatile("s_waitcnt lgkmcnt(0)" ::: "memory");
    f32x4 ya[8], yb[8];
#pragma unroll
    for (int i = 0; i < 8; ++i) { const LAS float* sp = T + (4 * i + rq) * 128 + (c8 ^ ((i & 1) * 32)); ya[i] = *(const LAS f32x4*)sp; yb[i] = *(const LAS f32x4*)(sp + 4); }
    asm volatile("s_waitcnt lgkmcnt(0)" ::: "memory"); __builtin_amdgcn_s_barrier(); asm volatile("" ::: "memory");
#pragma unroll
    for (int i = 0; i < 8; ++i) { u32x4 w;
        w.x = cvt_pk_bf16(ya[i].x * bf_lo(gz[i].x), ya[i].y * bf_hi(gz[i].x)); w.y = cvt_pk_bf16(ya[i].z * bf_lo(gz[i].y), ya[i].w * bf_hi(gz[i].y));
        w.z = cvt_pk_bf16(yb[i].x * bf_lo(gz[i].z), yb[i].y * bf_hi(gz[i].z)); w.w = cvt_pk_bf16(yb[i].z * bf_lo(gz[i].w), yb[i].w * bf_hi(gz[i].w));
        *(u32x4*)(A.YG + blk((int)rowb + wrow0 + 4 * i + rq, cbase + c8, NCT8)) = w; }
}

#undef TOFF
struct MemArgs { const bf16_t* QM; const bf16_t* KV; const bf16_t* SZ; bf16_t* YG; };
__device__ __forceinline__ void mem_unit(LAS unsigned char* lds, LAS float* wsc_all, const MemArgs& A, int b, int h, int qb, int half, int wid, int lane) {
    asm volatile("" : "+v"(lane));
    LAS float* wsc = wsc_all + wid * 64;
    const int r32 = lane & 31, hi = lane >> 5;
    const size_t qrow = (size_t)b * SEQ + qb * 256 + wid * 32;
    const bf16_t* Kb = A.KV + (size_t)b * MEMLEN * LD4 + h * MHD; const bf16_t* Vb = A.KV + (size_t)b * MEMLEN * LD4 + DMEMB + h * MHD + half * 256;
    const float C = 0.04419417382415922f * LOG2E;
    f32x16 p[8];
#pragma unroll
    for (int i = 0; i < 8; ++i) p[i] = (f32x16){};
    bf16x8 qr[8];
    asm volatile("" ::: "memory"); __builtin_amdgcn_s_barrier(); asm volatile("" ::: "memory");
    { int ln = lane; asm volatile("" : "+v"(ln)); const unsigned ko0 = dma_k_off(0, LD4, wid, ln), ko1 = dma_k_off(1, LD4, wid, ln);
#pragma unroll
      for (int kt = 0; kt < 4; ++kt) dma_k(lds, (unsigned)kt * 16384u, Kb + (size_t)kt * 64 * LD4, ko0, ko1, wid); }
    const bf16_t* Qw = A.QM + blk((int)qrow + r32, h * MHD + hi * 8, NCT2);
#pragma unroll
    for (int d0 = 0; d0 < 8; ++d0) qr[d0] = *(const bf16x8*)(Qw + d0 * 16);
#pragma unroll
    for (int c = 0; c < 4; ++c) {
        asm volatile("s_waitcnt vmcnt(0)" ::: "memory");
        asm volatile("" : "+v"(qr[0]), "+v"(qr[1]), "+v"(qr[2]), "+v"(qr[3]), "+v"(qr[4]), "+v"(qr[5]), "+v"(qr[6]), "+v"(qr[7]));
        __builtin_amdgcn_s_barrier(); asm volatile("" ::: "memory");
        if (c < 3) { int ln = lane; asm volatile("" : "+v"(ln)); const unsigned ko0 = dma_k_off(0, LD4, wid, ln), ko1 = dma_k_off(1, LD4, wid, ln);
#pragma unroll
            for (int kt = 0; kt < 4; ++kt) dma_k(lds, (unsigned)((c + 1) & 1) * 65536u + (unsigned)kt * 16384u, Kb + (size_t)kt * 64 * LD4 + (c + 1) * 128, ko0, ko1, wid);
        }
        const LAS unsigned char* Kc = lds + (c & 1) * 65536;
#pragma unroll
        for (int d0 = 0; d0 < 8; ++d0) { const int cb = (d0 * 16 + hi * 8) * 2;
#pragma unroll
            for (int kt = 0; kt < 4; ++kt) {
                const bf16x8 b0 = *(const LAS bf16x8*)(Kc + kt * 16384 + KSWZ(r32, cb));
                const bf16x8 b1 = *(const LAS bf16x8*)(Kc + kt * 16384 + KSWZ(32 + r32, cb));
                p[2 * kt] = __builtin_amdgcn_mfma_f32_32x32x16_bf16(b0, qr[d0], p[2 * kt], 0, 0, 0);
                p[2 * kt + 1] = __builtin_amdgcn_mfma_f32_32x32x16_bf16(b1, qr[d0], p[2 * kt + 1], 0, 0, 0); }
            SBAR();
            if (c < 3) qr[d0] = *(const bf16x8*)(A.QM + blk((int)qrow + r32, h * MHD + (c + 1) * 128 + hi * 8, NCT2) + d0 * 16);
            SBAR(); }
    }
    asm volatile("" ::: "memory"); __builtin_amdgcn_s_barrier(); asm volatile("" ::: "memory");
    { int ln = lane; asm volatile("" : "+v"(ln)); unsigned vo[4];
#pragma unroll
      for (int i = 0; i < 4; ++i) vo[i] = dma_v_off(i, LD4, wid, ln);
#pragma unroll
      for (int kt = 0; kt < 4; ++kt) dma_v(lds, (unsigned)kt * 32768u, Vb + (size_t)kt * 64 * LD4, vo, wid); }
    float pmax = p[0][0];
#pragma unroll
    for (int i = 0; i < 8; ++i)
#pragma unroll
        for (int r = 0; r < 16; ++r) pmax = fmaxf(pmax, p[i][r]);
    pmax = half_max(pmax);
    const float mn = pmax * C; float ps = 0.f;
#pragma unroll
    for (int i = 0; i < 8; ++i)
#pragma unroll
        for (int r = 0; r < 16; ++r) { p[i][r] = __builtin_amdgcn_exp2f(fmaf(p[i][r], C, -mn)); ps += p[i][r]; }
    ps = half_sum(ps);
    bf16x8 pa[4][4];
#pragma unroll
    for (int kt = 0; kt < 4; ++kt) { PK4(p[2 * kt], 0, pa[kt][0]); PK4(p[2 * kt], 8, pa[kt][1]); PK4(p[2 * kt + 1], 0, pa[kt][2]); PK4(p[2 * kt + 1], 8, pa[kt][3]); }
    f32x16 o[8];
#pragma unroll
    for (int d = 0; d < 8; ++d) o[d] = (f32x16){};
    const int vbase = (int)(unsigned)(uintptr_t)(lds) + v_rd_base(lane);
    asm volatile("s_waitcnt vmcnt(0)" ::: "memory"); __builtin_amdgcn_s_barrier(); asm volatile("" ::: "memory");
#pragma unroll
    for (int kt = 0; kt < 4; ++kt) pv_all(o, vbase + kt * 32768, pa[kt][0], pa[kt][1], pa[kt][2], pa[kt][3]);
    if (hi == 0) wsc[32 + r32] = ps;
    asm volatile("s_waitcnt lgkmcnt(0)" ::: "memory");
    float rli[16];
#pragma unroll
    for (int r = 0; r < 16; r += 4) { const f32x4 l4 = *(const LAS f32x4*)(wsc + 32 + 8 * (r >> 2) + 4 * hi);
#pragma unroll
        for (int e = 0; e < 4; ++e) rli[r + e] = __builtin_amdgcn_rcpf(l4[e]); }
    asm volatile("" ::: "memory"); __builtin_amdgcn_s_barrier(); asm volatile("" ::: "memory");
    const int c8 = (lane & 15) * 8, rq = lane >> 4;
    LAS float* T = (LAS float*)lds + wid * 4096;
    LAS float* Te = T + (4 * hi) * 128 + r32 + hi * 32; LAS float* To = T + (4 * hi) * 128 + r32 - hi * 32;
#pragma unroll
    for (int dq = 0; dq < 8; dq += 4) {
        const int cbase = DMIX + h * MHD + half * 256 + dq * 32;
        u32x4 gz[8];
#pragma unroll
        for (int i = 0; i < 8; ++i) gz[i] = *(const u32x4*)(A.SZ + blk((int)qrow + 4 * i + rq, cbase + c8, NCT8));
#pragma unroll
        for (int dd = 0; dd < 4; ++dd)
#pragma unroll
            for (int r = 0; r < 16; ++r) ((dd & 1) ? To : Te)[((r & 3) + 8 * (r >> 2)) * 128 + dd * 32] = o[dq + dd][r] * rli[r];
        asm volatile("s_waitcnt lgkmcnt(0)" ::: "memory");
        f32x4 ya[8], yb[8];
#pragma unroll
        for (int i = 0; i < 8; ++i) { const LAS float* sp = T + (4 * i + rq) * 128 + (c8 ^ ((i & 1) * 32)); ya[i] = *(const LAS f32x4*)sp; yb[i] = *(const LAS f32x4*)(sp + 4); }
        asm volatile("s_waitcnt lgkmcnt(0)" ::: "memory");
#pragma unroll
        for (int i = 0; i < 8; ++i) { u32x4 w;
            w.x = cvt_pk_bf16(ya[i].x * bf_lo(gz[i].x), ya[i].y * bf_hi(gz[i].x)); w.y = cvt_pk_bf16(ya[i].z * bf_lo(gz[i].y), ya[i].w * bf_hi(gz[i].y));
            w.z = cvt_pk_bf16(yb[i].x * bf_lo(gz[i].z), yb[i].y * bf_hi(gz[i].z)); w.w = cvt_pk_bf16(yb[i].z * bf_lo(gz[i].w), yb[i].w * bf_hi(gz[i].w));
            *(u32x4*)(A.YG + blk((int)qrow + 4 * i + rq, cbase + c8, NCT8)) = w; }
    }
    asm volatile("s_waitcnt lgkmcnt(0)" ::: "memory"); __builtin_amdgcn_s_barrier(); asm volatile("" ::: "memory");
}
#undef PK4
}

constexpr size_t MiB = 1u << 20;
constexpr size_t ws_up(size_t x) { return (x + MiB - 1) / MiB * MiB; }
constexpr size_t WS_CTL = 0, CTL_ZERO_BYTES = 1 * MiB;
constexpr size_t WS_WIN0T = 2 * MiB, WS_POOLWT = WS_WIN0T + ws_up((size_t)N0 * LD4 * 2), WS_WKV0T = WS_POOLWT + ws_up((size_t)4 * PGRP * LDP * 2), WS_WKV1T = WS_WKV0T + ws_up((size_t)DM * LD4 * 2);
constexpr size_t WS_WOUT0T = WS_WKV1T + ws_up((size_t)DM * LD4 * 2), WS_WOUT1T = WS_WOUT0T + ws_up((size_t)DM * LD8 * 2), WS_WIN1T = WS_WOUT1T + ws_up((size_t)DM * LD8 * 2);
constexpr size_t WS_H = WS_WIN1T + ws_up((size_t)N1 * LD4 * 2), WS_MN0 = WS_H + ws_up((size_t)M * LD4 * 2), WS_MN1 = WS_MN0 + ws_up((size_t)MROWS * LD4 * 2), WS_KV0 = WS_MN1 + ws_up((size_t)MROWS * LD4 * 2), WS_KV1 = WS_KV0 + ws_up((size_t)MROWS * LD4 * 2);
constexpr size_t WS_U = WS_KV1 + ws_up((size_t)MROWS * LD4 * 2), WS_PL = WS_U + ws_up((size_t)M * LD6 * 2), WS_V = WS_PL + ws_up((size_t)M * LD6 * 2), WS_QM = WS_V + ws_up((size_t)M * LD6 * 2);
constexpr size_t WS_SZ = WS_QM + ws_up((size_t)M * LD2 * 2), WS_YG = WS_SZ + ws_up((size_t)M * LD8 * 2), WS_X1 = WS_YG + ws_up((size_t)M * LD8 * 2), WS_X2 = WS_X1 + (size_t)M * DM * 4, WS_END = WS_X2 + (size_t)M * DM * 4;
static_assert(WS_END <= (size_t)1700 * MiB, "d_ws map");
constexpr int CW_BAR = 4096, CW_QUEUE = 16384, CW_ROWSS = 131072;
constexpr int RING_BYTES = 131072, WSC_OFF = RING_BYTES, MISC_OFF = WSC_OFF + 2048, LDS_BYTES = 147456;
constexpr int NWAVES = 8, NPHASE = 10;

#define XB_TMO      128
#define XB_XCNT(j)  (256  + 64 * (j))
#define XB_XSUB(j)  (1280 + 64 * (j))
#define XB_XGEN(j)  (2304 + 64 * (j))
#define XB_TOP      3328
#define XB_TOPGEN   3392
#define XCD_BAR_WORDS 3456
#define XB_SPIN_CAP (1u << 18)
__device__ __forceinline__ unsigned xb_ld(unsigned* p)              { return __hip_atomic_load(p, __ATOMIC_RELAXED, __HIP_MEMORY_SCOPE_AGENT); }
__device__ __forceinline__ unsigned xb_add(unsigned* p, unsigned v) { return __hip_atomic_fetch_add(p, v, __ATOMIC_RELAXED, __HIP_MEMORY_SCOPE_AGENT); }
__device__ __forceinline__ unsigned xb_xcc_id() { return (unsigned)__builtin_amdgcn_s_getreg((3 << 11) | 20) & 0xFu; }
#define XB_SPIN(cond, bar) do { unsigned _sp = 0; while (cond) { __builtin_amdgcn_s_sleep(1); \
    if ((++_sp & 255u) == 0u) { if (xb_ld(&(bar)[XB_TMO])) break; if (_sp > XB_SPIN_CAP) { atomicAdd(&(bar)[XB_TMO], 1u); break; } } } } while (0)
struct XcdBarrier { unsigned* bar; unsigned x; volatile LAS unsigned* st; };
__device__ __forceinline__ XcdBarrier xcd_barrier_post(unsigned* bar, volatile LAS unsigned* st) {
    XcdBarrier b; b.bar = bar; b.x = xb_xcc_id(); b.st = st;
    if (threadIdx.x == 0) (void)xb_add(&bar[XB_XCNT(b.x)], 1u);
    return b;
}
__device__ __forceinline__ void xcd_barrier_complete(unsigned* bar, unsigned x, unsigned& nloc, unsigned& nx) {
    const unsigned G = gridDim.x * gridDim.y * gridDim.z;
    unsigned sum, cnt, mine, sp = 0u;
    for (;;) {
        sum = 0u; cnt = 0u; mine = 0u;
#pragma unroll
        for (unsigned j = 0; j < 16; ++j) { const unsigned c = xb_ld(&bar[XB_XCNT(j)]); sum += c; cnt += (c > 0u) ? 1u : 0u; mine = (j == x) ? c : mine; }
        if (sum == G) break;
        __builtin_amdgcn_s_sleep(1);
        if ((++sp & 255u) == 0u) { if (xb_ld(&bar[XB_TMO])) break; if (sp > XB_SPIN_CAP) { atomicAdd(&bar[XB_TMO], 1u); break; } }
    }
    nloc = mine > 0u ? mine : 1u; nx = cnt > 0u ? cnt : 1u;
}
__device__ __forceinline__ void xcd_barrier(const XcdBarrier& b) {
    asm volatile("s_waitcnt vmcnt(0)" ::: "memory");
    __syncthreads();
    if (threadIdx.x == 0) {
        unsigned* bar = b.bar;
        __builtin_amdgcn_s_waitcnt(0);
        unsigned nloc = b.st[0], nx = b.st[1];
        if (nloc == 0u) { xcd_barrier_complete(bar, b.x, nloc, nx); b.st[0] = nloc; b.st[1] = nx; }
        const unsigned old = xb_add(&bar[XB_XSUB(b.x)], 1u);
        const unsigned gen = old / nloc;
        if (old + 1u == (gen + 1u) * nloc) {
            __builtin_amdgcn_fence(__ATOMIC_RELEASE, "agent");
            asm volatile("s_waitcnt vmcnt(0)" ::: "memory");
            const unsigned og = xb_add(&bar[XB_TOP], 1u);
            const unsigned tg = og / nx;
            if (og + 1u == (tg + 1u) * nx) xb_add(&bar[XB_TOPGEN], 1u);
            else XB_SPIN(xb_ld(&bar[XB_TOPGEN]) == tg, bar);
            __builtin_amdgcn_fence(__ATOMIC_ACQUIRE, "agent");
            xb_add(&bar[XB_XGEN(b.x)], 1u);
            asm volatile("s_waitcnt vmcnt(0)" ::: "memory");
        } else {
            XB_SPIN(xb_ld(&bar[XB_XGEN(b.x)]) == gen, bar);
            __builtin_amdgcn_fence(__ATOMIC_ACQUIRE, "agent");
            asm volatile("s_waitcnt vmcnt(0)" ::: "memory");
        }
    }
    __syncthreads();
}

__device__ __forceinline__ float wave_sum(float v) {
#pragma unroll
    for (int o = 1; o < 64; o <<= 1) v += __shfl_xor(v, o);
    return v;
}
__device__ __forceinline__ unsigned f2bf(float f) { unsigned u = __builtin_bit_cast(unsigned, f); return (u + 0x7fffu + ((u >> 16) & 1u)) >> 16; }
__device__ __forceinline__ unsigned pk2(float lo, float hi) { return cvt_pk_bf16(lo, hi); }
__device__ __forceinline__ void transpose_item(const float* W, int K, int N, bf16_t* WT, int ldt, LAS float* scr, int item, int lane, const float* rowgain = nullptr) {
    const int nblk = N / 32, kb = item / nblk, nb = item % nblk, k0 = 64 * kb, n0 = 32 * nb;
    float wv[32];
#pragma unroll
    for (int i = 0; i < 32; ++i) wv[i] = W[(size_t)(k0 + 2 * i + (lane >> 5)) * N + n0 + (lane & 31)];
    if (rowgain) {
#pragma unroll
        for (int i = 0; i < 32; ++i) wv[i] *= rowgain[k0 + 2 * i + (lane >> 5)]; }
#pragma unroll
    for (int i = 0; i < 32; ++i) scr[(2 * i + (lane >> 5)) * 33 + (lane & 31)] = wv[i];
    asm volatile("s_waitcnt lgkmcnt(0)" ::: "memory");
    const int c = lane & 7;
#pragma unroll
    for (int j = 0; j < 4; ++j) { const int n = (lane >> 3) + 8 * j; const LAS float* s = scr + (8 * c) * 33 + n;
        u32x4 o; o.x = pk2(s[0 * 33], s[1 * 33]); o.y = pk2(s[2 * 33], s[3 * 33]); o.z = pk2(s[4 * 33], s[5 * 33]); o.w = pk2(s[6 * 33], s[7 * 33]);
        *(u32x4*)(WT + (size_t)(n0 + n) * ldt + k0 + 8 * c) = o; }
    asm volatile("s_waitcnt lgkmcnt(0)" ::: "memory");
}
struct TrDesc { const float* W; bf16_t* WT; const float* gain; int N, ldt, k0, n0, nkt; };
__device__ __forceinline__ void tr_set(TrDesc& d, const float* W, int N, bf16_t* WT, int ldt, int item, const float* gain, int nkt = 0) {
    const int nblk = N / 32, kb = item / nblk, nb = item % nblk; d.W = W; d.WT = WT; d.gain = gain; d.N = N; d.ldt = ldt; d.k0 = 64 * kb; d.n0 = 32 * nb; d.nkt = nkt;
}
__device__ __forceinline__ void tr_load(const TrDesc& d, float (&wv)[32], int lane) {
#pragma unroll
    for (int i = 0; i < 32; ++i) wv[i] = d.W[(size_t)(d.k0 + 2 * i + (lane >> 5)) * d.N + d.n0 + (lane & 31)];
}
__device__ __forceinline__ void tr_finish(const TrDesc& d, float (&wv)[32], LAS float* scr, int lane) {
    if (d.gain) {
#pragma unroll
        for (int i = 0; i < 32; ++i) wv[i] *= d.gain[d.k0 + 2 * i + (lane >> 5)]; }
#pragma unroll
    for (int i = 0; i < 32; ++i) scr[(2 * i + (lane >> 5)) * 33 + (lane & 31)] = wv[i];
    asm volatile("s_waitcnt lgkmcnt(0)" ::: "memory");
    const int c = lane & 7;
#pragma unroll
    for (int j = 0; j < 4; ++j) { const int n = (lane >> 3) + 8 * j; const LAS float* sp = scr + (8 * c) * 33 + n;
        u32x4 o; o.x = pk2(sp[0 * 33], sp[1 * 33]); o.y = pk2(sp[2 * 33], sp[3 * 33]); o.z = pk2(sp[4 * 33], sp[5 * 33]); o.w = pk2(sp[6 * 33], sp[7 * 33]);
        const int nn = d.n0 + n, kk = d.k0 + 8 * c;
        bf16_t* dst = d.nkt ? d.WT + (((size_t)(nn >> 8) * d.nkt + (kk >> 8)) << 16) + ((nn & 255) << 8) + (kk & 255) : d.WT + (size_t)nn * d.ldt + kk;
        *(u32x4*)dst = o; }
    asm volatile("s_waitcnt lgkmcnt(0)" ::: "memory");
}
__device__ __forceinline__ void rms_row_bf16(const float* xrow, const float* g0, bf16_t* o0, const float* g1, bf16_t* o1, int lane) {
    const f32x4* xr = (const f32x4*)xrow + lane; f32x4 v[16]; float s = 0.f;
#pragma unroll
    for (int j = 0; j < 16; ++j) { v[j] = xr[64 * j]; s += (v[j].x * v[j].x + v[j].y * v[j].y) + (v[j].z * v[j].z + v[j].w * v[j].w); }
    const float rs = __builtin_amdgcn_rsqf(wave_sum(s) * (1.0f / DM) + RMS_EPS);
#pragma unroll
    for (int j = 0; j < 16; ++j) { const f32x4 gg = ((const f32x4*)g0)[lane + 64 * j]; const f32x4 y = v[j] * rs * gg;
        u32x2 w; w.x = pk2(y.x, y.y); w.y = pk2(y.z, y.w); ((u32x2*)o0)[lane + 64 * j] = w; }
    if (o1) {
#pragma unroll
        for (int j = 0; j < 16; ++j) { const f32x4 gg = ((const f32x4*)g1)[lane + 64 * j]; const f32x4 y = v[j] * rs * gg;
            u32x2 w; w.x = pk2(y.x, y.y); w.y = pk2(y.z, y.w); ((u32x2*)o1)[lane + 64 * j] = w; }
    }
}
__device__ __forceinline__ void rms_row2_bf16(const float* xa, const float* xb, const float* g0, bf16_t* oa, bf16_t* ob, int lane) {
    const f32x4* xra = (const f32x4*)xa + lane; const f32x4* xrb = (const f32x4*)xb + lane; f32x4 va[16], vb[16]; float sa = 0.f, sb = 0.f;
#pragma unroll
    for (int j = 0; j < 16; ++j) va[j] = xra[64 * j];
#pragma unroll
    for (int j = 0; j < 16; ++j) vb[j] = xrb[64 * j];
#pragma unroll
    for (int j = 0; j < 16; ++j) sa += (va[j].x * va[j].x + va[j].y * va[j].y) + (va[j].z * va[j].z + va[j].w * va[j].w);
#pragma unroll
    for (int j = 0; j < 16; ++j) sb += (vb[j].x * vb[j].x + vb[j].y * vb[j].y) + (vb[j].z * vb[j].z + vb[j].w * vb[j].w);
    const float ra = __builtin_amdgcn_rsqf(wave_sum(sa) * (1.0f / DM) + RMS_EPS), rb = __builtin_amdgcn_rsqf(wave_sum(sb) * (1.0f / DM) + RMS_EPS);
#pragma unroll
    for (int j = 0; j < 16; ++j) { const f32x4 gg = ((const f32x4*)g0)[lane + 64 * j]; const f32x4 ya = va[j] * ra * gg, yb = vb[j] * rb * gg;
        u32x2 w; w.x = pk2(ya.x, ya.y); w.y = pk2(ya.z, ya.w); ((u32x2*)oa)[lane + 64 * j] = w;
        u32x2 z; z.x = pk2(yb.x, yb.y); z.y = pk2(yb.z, yb.w); ((u32x2*)ob)[lane + 64 * j] = z; }
}
__device__ __forceinline__ void rms_row_f32(const float* xrow, const float* g, float* orow, int lane) {
    const f32x4* xr = (const f32x4*)xrow + lane; f32x4 v[16]; float s = 0.f;
#pragma unroll
    for (int j = 0; j < 16; ++j) { v[j] = xr[64 * j]; s += (v[j].x * v[j].x + v[j].y * v[j].y) + (v[j].z * v[j].z + v[j].w * v[j].w); }
    const float rs = __builtin_amdgcn_rsqf(wave_sum(s) * (1.0f / DM) + RMS_EPS);
#pragma unroll
    for (int j = 0; j < 16; ++j) { const f32x4 gg = ((const f32x4*)g)[lane + 64 * j]; ((f32x4*)orow)[lane + 64 * j] = v[j] * rs * gg; }
}
__device__ __forceinline__ void final_row(const bf16_t* xrow, const float* rowss, const float* g, float* orow, int lane) {
    const float rs = __builtin_amdgcn_rsqf(__hip_atomic_load(rowss, __ATOMIC_RELAXED, __HIP_MEMORY_SCOPE_AGENT) * (1.0f / DM) + RMS_EPS);
#pragma unroll
    for (int j = 0; j < 8; ++j) { const u32x4 w = ((const u32x4*)xrow)[lane + 64 * j]; const f32x4 g0 = ((const f32x4*)g)[2 * (lane + 64 * j)], g1 = ((const f32x4*)g)[2 * (lane + 64 * j) + 1];
        ((f32x4*)orow)[2 * (lane + 64 * j)] = (f32x4){bf_lo(w.x), bf_hi(w.x), bf_lo(w.y), bf_hi(w.y)} * rs * g0;
        ((f32x4*)orow)[2 * (lane + 64 * j) + 1] = (f32x4){bf_lo(w.z), bf_hi(w.z), bf_lo(w.w), bf_hi(w.w)} * rs * g1; }
}
__device__ __forceinline__ void final_row2(const bf16_t* xa, const bf16_t* xb, const float* ssa, const float* ssb, const float* g, float* oa, float* ob, int lane) {
    u32x4 wa[8], wb[8];
#pragma unroll
    for (int j = 0; j < 8; ++j) wa[j] = ((const u32x4*)xa)[lane + 64 * j];
#pragma unroll
    for (int j = 0; j < 8; ++j) wb[j] = ((const u32x4*)xb)[lane + 64 * j];
    const float ra = __builtin_amdgcn_rsqf(__hip_atomic_load(ssa, __ATOMIC_RELAXED, __HIP_MEMORY_SCOPE_AGENT) * (1.0f / DM) + RMS_EPS);
    const float rb = __builtin_amdgcn_rsqf(__hip_atomic_load(ssb, __ATOMIC_RELAXED, __HIP_MEMORY_SCOPE_AGENT) * (1.0f / DM) + RMS_EPS);
#pragma unroll
    for (int j = 0; j < 8; ++j) { const f32x4 g0 = ((const f32x4*)g)[2 * (lane + 64 * j)], g1 = ((const f32x4*)g)[2 * (lane + 64 * j) + 1];
        ((f32x4*)oa)[2 * (lane + 64 * j)] = (f32x4){bf_lo(wa[j].x), bf_hi(wa[j].x), bf_lo(wa[j].y), bf_hi(wa[j].y)} * ra * g0;
        ((f32x4*)oa)[2 * (lane + 64 * j) + 1] = (f32x4){bf_lo(wa[j].z), bf_hi(wa[j].z), bf_lo(wa[j].w), bf_hi(wa[j].w)} * ra * g1;
        ((f32x4*)ob)[2 * (lane + 64 * j)] = (f32x4){bf_lo(wb[j].x), bf_hi(wb[j].x), bf_lo(wb[j].y), bf_hi(wb[j].y)} * rb * g0;
        ((f32x4*)ob)[2 * (lane + 64 * j) + 1] = (f32x4){bf_lo(wb[j].z), bf_hi(wb[j].z), bf_lo(wb[j].w), bf_hi(wb[j].w)} * rb * g1; }
}
__device__ __forceinline__ void unpack8(const u32x4 w, float (&f)[8]) { f[0] = bf_lo(w.x); f[1] = bf_hi(w.x); f[2] = bf_lo(w.y); f[3] = bf_hi(w.y); f[4] = bf_lo(w.z); f[5] = bf_hi(w.z); f[6] = bf_lo(w.w); f[7] = bf_hi(w.w); }
#define UB(t_) (ub + (((size_t)((t_) >> 8) * NCT6) << 16) + (size_t)(((t_) & 255) << 8))
template <int W> __device__ __forceinline__ void pool_block(const bf16_t* ub, bf16_t* pb, int t0) {
    constexpr int NR = W - 1 + 16;
    u32x4 row[NR];
    if (t0 == 0) {
#pragma unroll
        for (int i = 0; i < NR; ++i) row[i] = (i >= W - 1) ? *(const u32x4*)UB(i - (W - 1)) : (u32x4){0u, 0u, 0u, 0u};
    } else {
#pragma unroll
        for (int i = 0; i < NR; ++i) row[i] = *(const u32x4*)UB(t0 - (W - 1) + i);
    }
    float s[8];
#pragma unroll
    for (int e = 0; e < 8; ++e) s[e] = 0.f;
#pragma unroll
    for (int i = 0; i < W - 1; ++i) { float f[8]; unpack8(row[i], f);
#pragma unroll
        for (int e = 0; e < 8; ++e) s[e] += f[e]; }
#pragma unroll
    for (int k = 0; k < 16; ++k) { const int t = t0 + k;
        float cur[8]; unpack8(row[W - 1 + k], cur);
        const float inv = 1.0f / (float)((t + 1) < W ? (t + 1) : W);
        float ov[8];
#pragma unroll
        for (int e = 0; e < 8; ++e) { s[e] += cur[e]; ov[e] = s[e] * inv - cur[e]; }
        u32x4 o; o.x = pk2(ov[0], ov[1]); o.y = pk2(ov[2], ov[3]); o.z = pk2(ov[4], ov[5]); o.w = pk2(ov[6], ov[7]);
        *(u32x4*)(pb + (size_t)t * LD6) = o;
        float f[8]; unpack8(row[k], f);
#pragma unroll
        for (int e = 0; e < 8; ++e) s[e] -= f[e]; }
}
__device__ __forceinline__ void pool_items(const bf16_t* U, bf16_t* P, int gw, int ngw, int lane) {
    for (int it = gw; it < NB * 128 * 12; it += ngw) {
        const int cg = it % 12, tc = (it / 12) % 128, b = it / (12 * 128), c0 = cg * 512 + lane * 8, t0 = tc * 16;
        const bf16_t* ub = U + (((size_t)(b * 8) * NCT6 + (c0 >> 8)) << 16) + (c0 & 255); bf16_t* pb = P + (size_t)b * SEQ * LD6 + c0;
        switch (cg / 3) { case 0: pool_block<2>(ub, pb, t0); break; case 1: pool_block<4>(ub, pb, t0); break; case 2: pool_block<8>(ub, pb, t0); break; default: pool_block<16>(ub, pb, t0); break; }
    }
}
#undef UB
struct Args { const float* in[20]; float* out; unsigned char* ws; int ph_lo, ph_hi, li, pad; };
__global__ void __launch_bounds__(NWAVES * 64, 2) fwd(Args args) {
    extern __shared__ __attribute__((aligned(16))) unsigned char lds_raw[];
    LAS unsigned char* lds = (LAS unsigned char*)lds_raw;
    const int tid = threadIdx.x, lane = tid & 63, wave = __builtin_amdgcn_readfirstlane(tid >> 6);
    const int G = gridDim.x, bx = blockIdx.x;
    const int vcu = (G % 8 == 0) ? (bx % 8) * (G / 8) + bx / 8 : bx;
    volatile LAS unsigned* MISC = (volatile LAS unsigned*)(lds + MISC_OFF);
    LAS float* wsc = (LAS float*)(lds + WSC_OFF);
    unsigned char* ws = args.ws;
    unsigned* ctl = (unsigned*)(ws + WS_CTL);
    for (int u = tid; u < (LDS_BYTES - MISC_OFF) / 4; u += NWAVES * 64) ((LAS unsigned*)(lds + MISC_OFF))[u] = 0u;
    __syncthreads();
    XcdBarrier bar; bar.bar = ctl + CW_BAR; bar.x = 0; bar.st = nullptr;
    if (!MK_PER_PHASE) bar = xcd_barrier_post(ctl + CW_BAR, MISC + 8);
    const int lo = args.ph_lo, hi_ph = args.ph_hi;
#ifndef PH_MASK
#define PH_MASK 0x3ff
#endif
#define IN(k) (((PH_MASK >> (k)) & 1) && lo <= (k) && (k) < hi_ph)
#define REP(k) for (int rep_ = 0; rep_ < ((REPEAT_PHASE == (k)) ? 2 : 1); ++rep_)
#define SEAM(k) do { if (IN(k) && IN((k) + 1)) xcd_barrier(bar); } while (0)
    const float* x = args.in[0]; const float* mem = args.in[1];
    bf16_t* win0t = (bf16_t*)(ws + WS_WIN0T); bf16_t* poolwt = (bf16_t*)(ws + WS_POOLWT); bf16_t* wkv0t = (bf16_t*)(ws + WS_WKV0T); bf16_t* wout0t = (bf16_t*)(ws + WS_WOUT0T);
    bf16_t* win1t = (bf16_t*)(ws + WS_WIN1T); bf16_t* wkv1t = (bf16_t*)(ws + WS_WKV1T); bf16_t* wout1t = (bf16_t*)(ws + WS_WOUT1T);
    bf16_t* hbuf = (bf16_t*)(ws + WS_H); bf16_t* mn0 = (bf16_t*)(ws + WS_MN0); bf16_t* mn1 = (bf16_t*)(ws + WS_MN1); bf16_t* kv0 = (bf16_t*)(ws + WS_KV0); bf16_t* kv1 = (bf16_t*)(ws + WS_KV1);
    bf16_t* ubuf = (bf16_t*)(ws + WS_U); bf16_t* plbuf = (bf16_t*)(ws + WS_PL); bf16_t* vbuf = (bf16_t*)(ws + WS_V); bf16_t* qmbuf = (bf16_t*)(ws + WS_QM); bf16_t* szbuf = (bf16_t*)(ws + WS_SZ);
    bf16_t* x2b = (bf16_t*)(ws + WS_X1); bf16_t* ygbuf = (bf16_t*)(ws + WS_YG);
    float* rowss1 = (float*)(ws + WS_CTL) + CW_ROWSS; float* rowss2 = rowss1 + M;
    const int gw = vcu * NWAVES + wave, NGW = G * NWAVES;

    if (IN(0)) REP(0) {
        LAS float* scr = (LAS float*)(lds + wave * 16384);
        constexpr int I_IN0 = (DM / 64) * (N0 / 32), I_PW = (PGRP / 64) * (PGRP / 32), I_KV = (DM / 64) * (DM / 32), I_OUT = (DI / 64) * (DM / 32), I_IN1 = (DM / 64) * (N1 / 32);
        for (int it = gw; it < 2 * I_KV; it += NGW) {
            if (it < I_KV) transpose_item(args.in[7], DM, DM, wkv0t, LD4, scr, it, lane); else transpose_item(args.in[17], DM, DM, wkv1t, LD4, scr, it - I_KV, lane); }
        for (int m = gw; m < MROWS; m += NGW) rms_row_bf16(mem + (size_t)m * DM, args.in[6], mn0 + (size_t)m * LD4, args.in[16], mn1 + (size_t)m * LD4, lane);
        if (!MK_PER_PHASE) xcd_barrier(bar);
        const int gh = G / 2;
        if (bx < gh) {
            pg8::Gemm g{mn0, wkv0t, LD4, LD4, DM, (size_t)(WS_MN1 - WS_MN0), (size_t)(WS_WKV1T - WS_WKV0T)}; pg8::Sched S; S.init(MROWS / 256, DM / 256, 2, gh, bx);
            pg8::EpiKV E{kv0, kv1};
            pg8::gemm_phase<pg8::EpiKV>(lds, g, S, E);
        } else {
            const int gw2 = (bx - gh) * NWAVES + wave, ngw2 = (G - gh) * NWAVES;
            for (int m = gw2; m < M; m += 2 * ngw2) {
                if (m + ngw2 < M) rms_row2_bf16(x + (size_t)m * DM, x + (size_t)(m + ngw2) * DM, args.in[2], hbuf + (size_t)m * LD4, hbuf + (size_t)(m + ngw2) * LD4, lane);
                else rms_row_bf16(x + (size_t)m * DM, args.in[2], hbuf + (size_t)m * LD4, nullptr, nullptr, lane); }
        }
        { constexpr int NQ = I_IN0 + 4 * I_PW + 2 * I_OUT + I_IN1, QSH = NQ / 8, QCH = 2; static_assert(NQ % 8 == 0 && QSH % QCH == 0, "queue shards");
          unsigned* qhead = ctl + CW_QUEUE;
#define Q_PULL(sh_) ({ unsigned v_ = 0u; if (lane == 0) v_ = __hip_atomic_fetch_add(qhead + 64 * (sh_), (unsigned)QCH, __ATOMIC_RELAXED, __HIP_MEMORY_SCOPE_AGENT); v_; })
#define TR_DECODE(d_, it_) do { int r = (it_);                                                                                                  \
            if (r < I_IN0) { tr_set(d_, args.in[3], N0, win0t, LD4, r, nullptr, DM / 256); break; } r -= I_IN0;                                                    \
            if (r < 4 * I_PW) { const int g = r / I_PW; tr_set(d_, args.in[4] + (size_t)g * PGRP * PGRP, PGRP, poolwt + (size_t)g * PGRP * LDP, LDP, r % I_PW, nullptr); break; } r -= 4 * I_PW; \
            if (r < I_OUT) { tr_set(d_, args.in[8], DM, wout0t, LD8, r, nullptr, DI / 256); break; } r -= I_OUT;                                                   \
            if (r < I_IN1) { tr_set(d_, args.in[10], N1, win1t, LD4, r, args.in[9], DM / 256); break; } r -= I_IN1;                                                \
            tr_set(d_, args.in[18], DM, wout1t, LD8, r, nullptr, DI / 256); } while (0)
          int shard = bx & 7, tried = 0; unsigned nxt_v = Q_PULL(shard);
          for (;;) {
              const unsigned cur = (unsigned)__builtin_amdgcn_readfirstlane((int)nxt_v);
              if (cur >= (unsigned)QSH) { if (++tried == 8) break; shard = (shard + 1) & 7; nxt_v = Q_PULL(shard); continue; }
              TrDesc d, e; float wv[32], wu[32]; const int base = shard * QSH + (int)cur;
              TR_DECODE(d, base); tr_load(d, wv, lane); TR_DECODE(e, base + 1); tr_load(e, wu, lane);
              nxt_v = Q_PULL(shard);
              tr_finish(d, wv, scr, lane); tr_finish(e, wu, scr, lane);
          }
#undef TR_DECODE
#undef Q_PULL
        }
    }
    SEAM(0);
    if (IN(1)) REP(1) {
        pg8::Gemm g{hbuf, win0t, LD4, 256, DM, 0, 0, 0, 1}; pg8::Sched S; S.init(M / 256, N0 / 256, 1, G, bx);
        pg8::EpiProj E{ubuf, ubuf, ubuf, qmbuf, szbuf, 24, 24, 24, 32, nullptr};
        pg8::gemm_phase<pg8::EpiProj>(lds, g, S, E);
    }
    SEAM(1);
    if (IN(2)) REP(2) { pool_items(ubuf, plbuf, gw, NGW, lane); }
    SEAM(2);
    if (IN(3)) REP(3) {
        { pg8::Gemm g{plbuf, poolwt, LD6, LDP, PGRP, (size_t)PGRP * 2, (size_t)PGRP * LDP * 2}; pg8::Sched S; S.init(M / 256, PGRP / 256, 4, G, bx);
          pg8::EpiPool E{szbuf, ygbuf, args.in[5]};
          pg8::gemm_phase<pg8::EpiPool>(lds, g, S, E); }
        { const att::MemArgs MA{qmbuf, kv0, szbuf, ygbuf};
          for (int u = bx; u < 256; u += G) att::mem_unit(lds, wsc, MA, u >> 6, (u >> 4) & 3, (u >> 1) & 7, u & 1, wave, lane); }
    }
    SEAM(3);
    if (IN(4)) REP(4) {
        pg8::Gemm g{ygbuf, wout0t, 256, 256, DI, 0, 0, 1, 1}; pg8::Sched S; S.init(M / 256, DM / 256, 1, G, bx);
        pg8::EpiResid<false> E{x, hbuf, rowss1};
        pg8::gemm_phase<pg8::EpiResid<false>>(lds, g, S, E);
    }
    SEAM(4);
    if (IN(6)) REP(6) {
        pg8::Gemm g{hbuf, win1t, LD4, 256, DM, 0, 0, 0, 1}; pg8::Sched S; S.init(M / 256, N1 / 256, 1, G, bx);
        pg8::EpiProj E{ubuf, plbuf, vbuf, qmbuf, szbuf, 24, 48, 72, 80, rowss1};
        pg8::gemm_phase<pg8::EpiProj>(lds, g, S, E);
    }
    SEAM(6);
    if (IN(7)) REP(7) {
        float d1 = args.in[11][lane] * args.in[12][lane] + args.in[11][lane + 64] * args.in[12][lane + 64];
        float d2 = args.in[13][lane] * args.in[14][lane] + args.in[13][lane + 64] * args.in[14][lane + 64];
        d1 = wave_sum(d1); d2 = wave_sum(d2);
        const float lam_init = 0.8f - 0.6f * 0.7408182206817179f;
        const float lam = __expf(d1) - __expf(d2) + lam_init;
        const att::DiffArgs DA{ubuf, plbuf, vbuf, szbuf, ygbuf, args.in[15], lam, 1.0f - lam_init};
        for (int it = bx; it < 768; it += G) {
            const int c = it & 255, rr = it >> 8, x = c & 7, j = c >> 3, k1 = rr * 4 + (j >> 4) * 2, qbi = j & 15;
            const int bh1 = x * 12 + k1, bh2 = bh1 + 1;
            att::diff_unit(lds, wsc, DA, bh1 / NHEAD, bh1 % NHEAD, qbi, 0, wave, lane);
            att::diff_unit(lds, wsc, DA, bh2 / NHEAD, bh2 % NHEAD, 15 - qbi, 1, wave, lane);
        }
        const att::MemArgs MA{qmbuf, kv1, szbuf, ygbuf};
        for (int u = bx; u < 256; u += G) att::mem_unit(lds, wsc, MA, u >> 6, (u >> 4) & 3, (u >> 1) & 7, u & 1, wave, lane);
    }
    SEAM(7);
    if (IN(8)) REP(8) {
        pg8::Gemm g{ygbuf, wout1t, 256, 256, DI, 0, 0, 1, 1}; pg8::Sched S; S.init(M / 256, DM / 256, 1, G, bx);
        pg8::EpiResid<true> E{hbuf, x2b, rowss2};
        pg8::gemm_phase<pg8::EpiResid<true>>(lds, g, S, E);
    }
    SEAM(8);
    if (IN(9)) REP(9) {
        for (int m = gw; m < M; m += 2 * NGW) {
            if (m + NGW < M) final_row2(x2b + (size_t)m * LD4, x2b + (size_t)(m + NGW) * LD4, rowss2 + m, rowss2 + m + NGW, args.in[19], args.out + (size_t)m * DM, args.out + (size_t)(m + NGW) * DM, lane);
            else final_row(x2b + (size_t)m * LD4, rowss2 + m, args.in[19], args.out + (size_t)m * DM, lane);
        }
    }
#undef IN
#undef SEAM
}

extern "C" void kernel_launch(void* const* d_in, const int* in_sizes, int n_in, void* d_out, int out_size, void* d_ws, size_t ws_size, hipStream_t stream) {
    static int grid = 0;
    if (grid == 0) {
        if (n_in != 20 || out_size != M * DM || ws_size < WS_END) { fprintf(stderr, "kernel_launch: unexpected shapes (n_in %d out %d ws %zu)\n", n_in, out_size, ws_size); grid = -1; return; }
        int dev = 0, cus = 0, per_cu = 0;
        if (hipGetDevice(&dev) != hipSuccess || hipDeviceGetAttribute(&cus, hipDeviceAttributeMultiprocessorCount, dev) != hipSuccess) { grid = -1; return; }
        if (hipFuncSetAttribute((const void*)fwd, hipFuncAttributeMaxDynamicSharedMemorySize, LDS_BYTES) != hipSuccess) { fprintf(stderr, "kernel_launch: hipFuncSetAttribute failed\n"); grid = -1; return; }
        if (hipOccupancyMaxActiveBlocksPerMultiprocessor(&per_cu, (const void*)fwd, NWAVES * 64, LDS_BYTES) != hipSuccess || per_cu < 1)
            fprintf(stderr, "kernel_launch: occupancy query reports %d blocks per CU\n", per_cu);
        (void)hipGetLastError();
        grid = cus;
    }
    if (grid < 0) return;
    (void)hipMemsetAsync((char*)d_ws + WS_CTL, 0, CTL_ZERO_BYTES, stream);
    Args a{};
    for (int i = 0; i < 20; ++i) a.in[i] = (const float*)d_in[i];
    a.out = (float*)d_out; a.ws = (unsigned char*)d_ws; a.pad = 0;
#if MK_PER_PHASE
    for (int p = 0; p < NPHASE; ++p) { a.ph_lo = p; a.ph_hi = p + 1; a.li = p; hipLaunchKernelGGL(fwd, dim3(grid), dim3(NWAVES * 64), LDS_BYTES, stream, a); }
#else
    a.ph_lo = 0; a.ph_hi = NPHASE; a.li = 0;
    hipLaunchKernelGGL(fwd, dim3(grid), dim3(NWAVES * 64), LDS_BYTES, stream, a);
#endif
    const hipError_t le = hipPeekAtLastError();
    if (le != hipSuccess) fprintf(stderr, "kernel_launch: launch failed: %s\n", hipGetErrorName(le));
}
```

```cpp
#include <hip/hip_runtime.h>
#include <cstdio>
#include <cstdint>

#ifndef REPEAT_PHASE
#define REPEAT_PHASE -1
#endif
#ifndef EPI_NT
#define EPI_NT 0
#endif
#ifndef PG8_SP2
#define PG8_SP2 1
#endif
#ifndef MK_PER_PHASE
#define MK_PER_PHASE 0
#endif

#define LAS __attribute__((address_space(3)))
#define GAS __attribute__((address_space(1)))
typedef unsigned short bf16_t;
typedef short bf16x8 __attribute__((ext_vector_type(8)));
typedef short s16x4 __attribute__((ext_vector_type(4)));
typedef float f32x4 __attribute__((ext_vector_type(4)));
typedef float f32x2 __attribute__((ext_vector_type(2)));
typedef float f32x16 __attribute__((ext_vector_type(16)));
typedef unsigned u32x4 __attribute__((ext_vector_type(4)));
typedef unsigned u32x2 __attribute__((ext_vector_type(2)));

constexpr int DM = 4096, SEQ = 2048, NB = 4, M = NB * SEQ, DI = 8192, DMEMB = 2048, DMIX = 6144, MEMLEN = 256, MHD = 512, PGRP = 1536, NHEAD = 24;
constexpr int N0 = 16384, N1 = 28672, MROWS = NB * MEMLEN;
constexpr int PADE = 128, LD4 = DM + PADE, LD8 = DI + PADE, LD6 = DMIX + PADE, LD2 = DMEMB + PADE, LDP = PGRP + PADE;
constexpr int NCT6 = DMIX / 256, NCT2 = DMEMB / 256, NCT8 = DI / 256;
__device__ __forceinline__ size_t blk(int row, int col, int nct) { return ((size_t)((row >> 8) * nct + (col >> 8)) << 16) + (size_t)(((row & 255) << 8) + (col & 255)); }
constexpr float RMS_EPS = 1e-6f, SUBLN_EPS = 1e-5f;
constexpr float LOG2E = 1.4426950408889634f;

__device__ __forceinline__ unsigned cvt_pk_bf16(float lo, float hi) { unsigned r; asm volatile("v_cvt_pk_bf16_f32 %0, %1, %2" : "=v"(r) : "v"(lo), "v"(hi)); return r; }
__device__ __forceinline__ float bf_lo(unsigned w) { return __uint_as_float(w << 16); }
__device__ __forceinline__ float bf_hi(unsigned w) { return __uint_as_float(w & 0xffff0000u); }
__device__ __forceinline__ float silu_f(float v) { return v * __builtin_amdgcn_rcpf(1.0f + __builtin_amdgcn_exp2f(-LOG2E * v)); }

namespace pg8 {
constexpr int BM = 256, BK = 64, HALF = 128, HTB = HALF * BK * 2, STAGE_BYTES = 8 * HTB, NXCD = 8, WGM = 8;
__host__ __device__ __forceinline__ int lds_byte(int r, int c) { const int st = (r >> 4) * 2 + (c >> 5), rr = r & 15, cc = c & 31, ob = rr * 64 + cc * 2; return st * 1024 + (ob ^ (((ob >> 9) & 1) << 5)); }
__host__ __device__ __forceinline__ void stage_rc(int b, int& R, int& C) { const int st = b / 1024, sb = b % 1024, swz = sb ^ (((sb >> 9) & 1) << 5); R = (st >> 1) * 16 + swz / 64; C = (st & 1) * 32 + (swz % 64) / 2; }
__host__ __device__ __forceinline__ int perm32(int rho) { const int n = rho >> 4, i = rho & 15; return 8 * (i >> 2) + 4 * n + (i & 3); }

struct Unit { int pm, pn, g; };
struct Gemm { const bf16_t* A; const bf16_t* Bt; int lda, ldb, K; size_t gsA, gsB; int ablk = 0, bblk = 0; };

__device__ __forceinline__ void tile_map(int wgid, int nM, int nN, int& pm, int& pn) {
    const int nwg = nM * nN;
    { const int q = nwg / NXCD, r = nwg % NXCD, xcd = wgid % NXCD, off = wgid / NXCD; wgid = (xcd < r ? xcd * (q + 1) : r * (q + 1) + (xcd - r) * q) + off; }
    const int nig = WGM * nN, gid = wgid / nig, fm = gid * WGM, gsz = (nM - fm) < WGM ? (nM - fm) : WGM;
    pm = fm + ((wgid % nig) % gsz); pn = (wgid % nig) / gsz;
}
struct Sched {
    int nM, nN, per, total, G, c, pnon = 0;
    __device__ void init(int nM_, int nN_, int ngroups, int G_, int c_) { nM = nM_; nN = nN_; per = nM_ * nN_; total = per * ngroups; G = G_; c = c_; }
    __device__ __forceinline__ bool next(int i, Unit& u) const {
        const int L = i * G + c; if (L >= total || c >= G) return false;
        u.g = L / per; tile_map(L % per, nM, nN, u.pm, u.pn);
        if (pnon) { const int H = nN >> 1, hp = pnon >> 1, ha = H - hp, h = u.pn / H, j = u.pn % H; u.pn = j < hp ? h * hp + j : pnon + h * ha + (j - hp); }
        return true;
    }
};

__device__ __forceinline__ void store8(bf16_t* p, f32x4 v0, f32x4 v1) {
    u32x4 w; w.x = cvt_pk_bf16(v0[0], v0[1]); w.y = cvt_pk_bf16(v0[2], v0[3]); w.z = cvt_pk_bf16(v1[0], v1[1]); w.w = cvt_pk_bf16(v1[2], v1[3]);
#if EPI_NT
    __builtin_nontemporal_store(w, (u32x4*)p);
#else
    *(u32x4*)p = w;
#endif
}
struct EpiProj {
    static constexpr bool PERM = true;
    bf16_t *b0, *b1, *b2, *b3, *b4; int e0, e1, e2, e3;
    const float* rowss;
    __device__ __forceinline__ void pre(const Unit& u, int wr, int fr, float (&rq)[2][4]) const {
#pragma unroll
        for (int ai = 0; ai < 2; ++ai)
#pragma unroll
            for (int m = 0; m < 4; ++m) rq[ai][m] = rowss ? __hip_atomic_load(rowss + u.pm * BM + wr * 64 + fr + ai * HALF + m * 16, __ATOMIC_RELAXED, __HIP_MEMORY_SCOPE_AGENT) : 0.f;
    }
    __device__ __forceinline__ void operator()(const f32x4 (&acc)[2][2][4][2], const Unit& u, int wr, int wc, int fr, int fq, const float (&rq)[2][4]) const {
        const int pn = u.pn; bf16_t* base; int nct, ct; bool act = false;
        if (pn < e0) { base = b0; nct = NCT6; ct = pn; }
        else if (pn < e1) { base = b1; nct = NCT6; ct = pn - e0; }
        else if (pn < e2) { base = b2; nct = NCT6; ct = pn - e1; }
        else if (pn < e3) { base = b3; nct = NCT2; ct = pn - e2; }
        else { base = b4; nct = NCT8; ct = pn - e3; act = true; }
        bf16_t* tile = base + ((size_t)(u.pm * nct + ct) << 16) + (wr * 64 + fr) * 256 + wc * 32 + 8 * fq;
        float rs[2][4];
#pragma unroll
        for (int ai = 0; ai < 2; ++ai)
#pragma unroll
            for (int m = 0; m < 4; ++m) rs[ai][m] = rowss ? __builtin_amdgcn_rsqf(rq[ai][m] * (1.0f / DM) + RMS_EPS) : 1.0f;
#pragma unroll
        for (int ai = 0; ai < 2; ++ai)
#pragma unroll
            for (int m = 0; m < 4; ++m) { bf16_t* rowp = tile + (ai * HALF + m * 16) * 256;
#pragma unroll
                for (int bj = 0; bj < 2; ++bj) { f32x4 v0 = acc[ai][bj][m][0] * rs[ai][m], v1 = acc[ai][bj][m][1] * rs[ai][m];
                    if (act) {
#pragma unroll
                        for (int j = 0; j < 4; ++j) { v0[j] = silu_f(v0[j]); v1[j] = silu_f(v1[j]); } }
                    store8(rowp + bj * HALF, v0, v1); } }
    }
};
struct EpiKV {
    static constexpr bool PERM = true;
    bf16_t *o0, *o1;
    __device__ __forceinline__ void pre(const Unit&, int, int, float (&)[2][4]) const {}
    __device__ __forceinline__ void operator()(const f32x4 (&acc)[2][2][4][2], const Unit& u, int wr, int wc, int fr, int fq, const float (&)[2][4]) const {
        bf16_t* base = u.g ? o1 : o0; const int row0 = u.pm * BM + wr * 64 + fr, col0 = u.pn * BM + wc * 32 + 8 * fq;
#pragma unroll
        for (int ai = 0; ai < 2; ++ai)
#pragma unroll
            for (int m = 0; m < 4; ++m) { bf16_t* rowp = base + (size_t)(row0 + ai * HALF + m * 16) * LD4 + col0;
#pragma unroll
                for (int bj = 0; bj < 2; ++bj) store8(rowp + bj * HALF, acc[ai][bj][m][0], acc[ai][bj][m][1]); }
    }
};
struct EpiPool {
    static constexpr bool PERM = true;
    const bf16_t* sz; bf16_t* yg; const float* scale;
    __device__ __forceinline__ void pre(const Unit&, int, int, float (&)[2][4]) const {}
    __device__ __forceinline__ void operator()(const f32x4 (&acc)[2][2][4][2], const Unit& u, int wr, int wc, int fr, int fq, const float (&)[2][4]) const {
        const int col0 = u.g * PGRP + u.pn * BM + wc * 32 + 8 * fq;
        const size_t t0 = ((size_t)(u.pm * NCT8 + u.g * (PGRP / 256) + u.pn) << 16) + (wr * 64 + fr) * 256 + wc * 32 + 8 * fq;
        f32x4 sc[2][2];
#pragma unroll
        for (int bj = 0; bj < 2; ++bj) { sc[bj][0] = *(const f32x4*)(scale + col0 + bj * HALF); sc[bj][1] = *(const f32x4*)(scale + col0 + bj * HALF + 4); }
        u32x4 zv[2][4][2];
#pragma unroll
        for (int ai = 0; ai < 2; ++ai)
#pragma unroll
            for (int m = 0; m < 4; ++m)
#pragma unroll
                for (int bj = 0; bj < 2; ++bj) zv[ai][m][bj] = *(const u32x4*)(sz + t0 + (ai * HALF + m * 16) * 256 + bj * HALF);
#pragma unroll
        for (int ai = 0; ai < 2; ++ai) {
#pragma unroll
            for (int m = 0; m < 4; ++m) { bf16_t* rowp = yg + t0 + (ai * HALF + m * 16) * 256;
#pragma unroll
                for (int bj = 0; bj < 2; ++bj) { const u32x4 z = zv[ai][m][bj];
                    f32x4 v0 = acc[ai][bj][m][0] * sc[bj][0], v1 = acc[ai][bj][m][1] * sc[bj][1];
                    v0[0] *= bf_lo(z.x); v0[1] *= bf_hi(z.x); v0[2] *= bf_lo(z.y); v0[3] *= bf_hi(z.y);
                    v1[0] *= bf_lo(z.z); v1[1] *= bf_hi(z.z); v1[2] *= bf_lo(z.w); v1[3] *= bf_hi(z.w);
                    store8(rowp + bj * HALF, v0, v1); } } }
    }
};
template <bool RESBF> struct EpiResid {
    static constexpr bool PERM = true;
    const void* res; bf16_t* outb; float* rowss;
    __device__ __forceinline__ void pre(const Unit&, int, int, float (&)[2][4]) const {}
    __device__ __forceinline__ void operator()(const f32x4 (&acc)[2][2][4][2], const Unit& u, int wr, int wc, int fr, int fq, const float (&)[2][4]) const {
        const int row0 = u.pm * BM + wr * 64 + fr, col0 = u.pn * BM + wc * 32 + 8 * fq;
        u32x4 rw[2][4][2];
        if constexpr (RESBF) {
#pragma unroll
            for (int ai = 0; ai < 2; ++ai)
#pragma unroll
                for (int m = 0; m < 4; ++m)
#pragma unroll
                    for (int bj = 0; bj < 2; ++bj) rw[ai][m][bj] = *(const u32x4*)((const bf16_t*)res + (size_t)(row0 + ai * HALF + m * 16) * LD4 + col0 + bj * HALF);
        }
#pragma unroll
        for (int ai = 0; ai < 2; ++ai) {
            f32x4 rv[4][2][2];
#pragma unroll
            for (int m = 0; m < 4; ++m)
#pragma unroll
                for (int bj = 0; bj < 2; ++bj) { const int row = row0 + ai * HALF + m * 16, col = col0 + bj * HALF;
                    if constexpr (RESBF) { const u32x4 w = rw[ai][m][bj];
                        rv[m][bj][0] = (f32x4){bf_lo(w.x), bf_hi(w.x), bf_lo(w.y), bf_hi(w.y)}; rv[m][bj][1] = (f32x4){bf_lo(w.z), bf_hi(w.z), bf_lo(w.w), bf_hi(w.w)}; }
                    else { const float* rp = (const float*)res + (size_t)row * DM + col; rv[m][bj][0] = *(const f32x4*)rp; rv[m][bj][1] = *(const f32x4*)(rp + 4); } }
#pragma unroll
            for (int m = 0; m < 4; ++m) { const int row = row0 + ai * HALF + m * 16; float ssq = 0.f;
#pragma unroll
                for (int bj = 0; bj < 2; ++bj) { const f32x4 v0 = rv[m][bj][0] + acc[ai][bj][m][0], v1 = rv[m][bj][1] + acc[ai][bj][m][1];
                    ssq += (v0[0] * v0[0] + v0[1] * v0[1]) + (v0[2] * v0[2] + v0[3] * v0[3]) + (v1[0] * v1[0] + v1[1] * v1[1]) + (v1[2] * v1[2] + v1[3] * v1[3]);
                    store8(outb + (size_t)row * LD4 + col0 + bj * HALF, v0, v1); }
                ssq += __shfl_xor(ssq, 16); ssq += __shfl_xor(ssq, 32);
                if (fq == 0) (void)__hip_atomic_fetch_add(rowss + row, ssq, __ATOMIC_RELAXED, __HIP_MEMORY_SCOPE_AGENT); } }
    }
};
template <class Epi>
__device__ __forceinline__ void gemm_phase(LAS unsigned char* lds, const Gemm g, const Sched& S, const Epi& E) {
    const int tid = threadIdx.x, wid = __builtin_amdgcn_readfirstlane(tid >> 6), lane = tid & 63, wr = wid >> 2, wc = wid & 3, fr = lane & 15, fq = lane >> 4;
    const int nt = g.K / BK;
    unsigned voffA[2], voffB[2];
#pragma unroll
    for (int i = 0; i < 2; ++i) { int R, C; stage_rc(tid * 16 + i * 8192, R, C); const int Rb = Epi::PERM ? ((R & ~31) + perm32(R & 31)) : R;
        voffA[i] = (unsigned)(R * g.lda + C) * 2u; voffB[i] = (unsigned)(Rb * g.ldb + C) * 2u; }
    const size_t kstep = (size_t)(BK * 2);
    const size_t hA = (size_t)HALF * g.lda * 2, hB = (size_t)HALF * g.ldb * 2, tA = g.ablk ? ((size_t)(g.K >> 8) << 17) : 2 * hA, tB = g.bblk ? ((size_t)(g.K >> 8) << 17) : 2 * hB;
#define KOA(t_) (g.ablk ? (((size_t)((t_) >> 2) << 17) + (size_t)((t_) & 3) * 128) : (size_t)(t_) * kstep)
#define KOB(t_) (g.bblk ? (((size_t)((t_) >> 2) << 17) + (size_t)((t_) & 3) * 128) : (size_t)(t_) * kstep)
    const unsigned ldsw = (unsigned)wid * 1024u;
    const int aoff = lds_byte(wr * 64 + fr, fq * 8), boff = lds_byte(wc * 32 + fr, fq * 8);
#define PG8_SA(b, h) (((b) * 2 + (h)) * HTB)
#define PG8_SB(b, h) ((4 + (b) * 2 + (h)) * HTB)
#define PG8_STAGE(bufoff, gbase, voff) do { _Pragma("unroll") for (int _i = 0; _i < 2; ++_i) \
        __builtin_amdgcn_global_load_lds((const unsigned*)((const char*)(gbase) + (voff)[_i]), (LAS unsigned*)(lds + (bufoff) + ldsw + _i * 8192), 16, 0, 0); } while (0)
#define PG8_LDA(dst, b, h) do { _Pragma("unroll") for (int m = 0; m < 4; ++m) _Pragma("unroll") for (int k = 0; k < 2; ++k) dst[m][k] = *(const LAS bf16x8*)(lds + PG8_SA(b, h) + aoff + m * 2048 + k * 1024); } while (0)
#define PG8_LDB(dst, b, h) do { _Pragma("unroll") for (int n = 0; n < 2; ++n) _Pragma("unroll") for (int k = 0; k < 2; ++k) dst[n][k] = *(const LAS bf16x8*)(lds + PG8_SB(b, h) + boff + n * 2048 + k * 1024); } while (0)
#define PG8_MMA(ai, bj, At, Bt) do { __builtin_amdgcn_s_setprio(1); _Pragma("unroll") for (int m = 0; m < 4; ++m) _Pragma("unroll") for (int n = 0; n < 2; ++n) _Pragma("unroll") for (int k = 0; k < 2; ++k) \
        acc[ai][bj][m][n] = __builtin_amdgcn_mfma_f32_16x16x32_bf16(Bt[n][k], At[m][k], acc[ai][bj][m][n], 0, 0, 0); __builtin_amdgcn_s_setprio(0); } while (0)
#define PG8_WAIT_V(n) asm volatile("s_waitcnt vmcnt(" #n ")" ::: "memory")
#define PG8_WAIT_L(n) asm volatile("s_waitcnt lgkmcnt(" #n ")" ::: "memory")
#define PG8_BAR __builtin_amdgcn_s_barrier()
#define PG8_SCHED __builtin_amdgcn_sched_barrier(0)
    Unit cur, nxt; int ui = 0;
    if (!S.next(0, cur)) return;
    f32x4 acc[2][2][4][2];
#pragma unroll
    for (int a = 0; a < 2; ++a)
#pragma unroll
        for (int b = 0; b < 2; ++b)
#pragma unroll
            for (int m = 0; m < 4; ++m)
#pragma unroll
                for (int n = 0; n < 2; ++n) acc[a][b][m][n] = (f32x4){0.f, 0.f, 0.f, 0.f};
    float rq[2][4]; E.pre(cur, wr, fr, rq);
    bf16x8 At[4][2], B0[2][2], B1[2][2];
    const char* cA = (const char*)g.A + (size_t)cur.g * g.gsA + (size_t)cur.pm * tA; const char* cB = (const char*)g.Bt + (size_t)cur.g * g.gsB + (size_t)cur.pn * tB;
#if PG8_SP2
    PG8_STAGE(PG8_SB(0, 0), cB, voffB); PG8_STAGE(PG8_SB(0, 1), cB + hB, voffB); PG8_STAGE(PG8_SA(0, 0), cA, voffA); PG8_STAGE(PG8_SA(0, 1), cA + hA, voffA);
    if (wr == 1) PG8_BAR;
    PG8_WAIT_V(2); PG8_BAR;
    PG8_STAGE(PG8_SB(1, 0), cB + KOB(1), voffB); PG8_STAGE(PG8_SA(1, 0), cA + KOA(1), voffA); PG8_STAGE(PG8_SB(1, 1), cB + hB + KOB(1), voffB);
    PG8_WAIT_V(6); PG8_BAR;
#else
    PG8_STAGE(PG8_SB(0, 0), cB, voffB); PG8_STAGE(PG8_SA(0, 0), cA, voffA); PG8_STAGE(PG8_SB(0, 1), cB + hB, voffB); PG8_STAGE(PG8_SA(0, 1), cA + hA, voffA);
    if (wr == 1) PG8_BAR;
    PG8_WAIT_V(4); PG8_BAR;
    PG8_STAGE(PG8_SB(1, 0), cB + KOB(1), voffB); PG8_STAGE(PG8_SA(1, 0), cA + KOA(1), voffA); PG8_STAGE(PG8_SB(1, 1), cB + hB + KOB(1), voffB);
    PG8_WAIT_V(6); PG8_BAR;
#endif
    for (;;) {
        const bool has_next = S.next(ui + 1, nxt);
        const char* nA = has_next ? (const char*)g.A + (size_t)nxt.g * g.gsA + (size_t)nxt.pm * tA : cA; const char* nB = has_next ? (const char*)g.Bt + (size_t)nxt.g * g.gsB + (size_t)nxt.pn * tB : cB;
        for (int t = 0; t < nt; t += 2) {
            const bool last = (t == nt - 2);
            const char* a1 = cA + KOA(t + 1);
            const char* a2 = last ? nA : cA + KOA(t + 2); const char* b2 = last ? nB : cB + KOB(t + 2);
            const char* a3 = last ? nA + KOA(1) : cA + KOA(t + 3); const char* b3 = last ? nB + KOB(1) : cB + KOB(t + 3);
#if PG8_SP2
            PG8_LDB(B0, 0, 0); PG8_LDB(B1, 0, 1); PG8_SCHED; PG8_LDA(At, 0, 0); PG8_STAGE(PG8_SA(1, 1), a1 + hA, voffA);
            PG8_WAIT_V(8); PG8_WAIT_L(0); PG8_BAR; PG8_MMA(0, 0, At, B0); PG8_MMA(0, 1, At, B1); PG8_BAR; PG8_SCHED;
            PG8_LDA(At, 0, 1); PG8_STAGE(PG8_SB(0, 0), b2, voffB); PG8_STAGE(PG8_SB(0, 1), b2 + hB, voffB); PG8_STAGE(PG8_SA(0, 0), a2, voffA);
            PG8_WAIT_V(8); PG8_WAIT_L(0); PG8_BAR; PG8_MMA(1, 0, At, B0); PG8_MMA(1, 1, At, B1); PG8_BAR; PG8_SCHED;
            PG8_LDB(B0, 1, 0); PG8_LDB(B1, 1, 1); PG8_SCHED; PG8_LDA(At, 1, 0); PG8_STAGE(PG8_SA(0, 1), a2 + hA, voffA);
            PG8_WAIT_V(8); PG8_WAIT_L(0); PG8_BAR; PG8_MMA(0, 0, At, B0); PG8_MMA(0, 1, At, B1); PG8_BAR; PG8_SCHED;
            PG8_LDA(At, 1, 1); PG8_STAGE(PG8_SB(1, 0), b3, voffB); PG8_STAGE(PG8_SB(1, 1), b3 + hB, voffB); PG8_STAGE(PG8_SA(1, 0), a3, voffA);
            PG8_WAIT_V(8); PG8_WAIT_L(0); PG8_BAR; PG8_MMA(1, 0, At, B0); PG8_MMA(1, 1, At, B1); PG8_BAR; PG8_SCHED;
        #else
            PG8_LDB(B0, 0, 0); PG8_SCHED; PG8_LDA(At, 0, 0); PG8_STAGE(PG8_SA(1, 1), a1 + hA, voffA);
            PG8_WAIT_L(8); PG8_BAR; PG8_WAIT_L(0); PG8_MMA(0, 0, At, B0); PG8_BAR; PG8_SCHED;
            PG8_LDB(B1, 0, 1); PG8_STAGE(PG8_SB(0, 0), b2, voffB);
            PG8_BAR; PG8_WAIT_L(0); PG8_MMA(0, 1, At, B1); PG8_BAR;
            PG8_LDA(At, 0, 1); PG8_STAGE(PG8_SA(0, 0), a2, voffA);
            PG8_BAR; PG8_WAIT_L(0); PG8_MMA(1, 0, At, B0); PG8_BAR; PG8_SCHED;
            PG8_STAGE(PG8_SB(0, 1), b2 + hB, voffB);
            PG8_WAIT_V(6); PG8_BAR; PG8_MMA(1, 1, At, B1); PG8_BAR;
            PG8_LDB(B0, 1, 0); PG8_SCHED; PG8_LDA(At, 1, 0); PG8_STAGE(PG8_SA(0, 1), a2 + hA, voffA);
            PG8_WAIT_L(8); PG8_BAR; PG8_WAIT_L(0); PG8_MMA(0, 0, At, B0); PG8_BAR; PG8_SCHED;
            PG8_LDB(B1, 1, 1); PG8_STAGE(PG8_SB(1, 0), b3, voffB);
            PG8_BAR; PG8_WAIT_L(0); PG8_MMA(0, 1, At, B1); PG8_BAR;
            PG8_LDA(At, 1, 1); PG8_STAGE(PG8_SA(1, 0), a3, voffA);
            PG8_BAR; PG8_WAIT_L(0); PG8_MMA(1, 0, At, B0); PG8_BAR; PG8_SCHED;
            PG8_STAGE(PG8_SB(1, 1), b3 + hB, voffB);
            PG8_WAIT_V(6); PG8_BAR; PG8_MMA(1, 1, At, B1); PG8_BAR;
#endif
        }
        if (wr == 0) PG8_BAR;
        E(acc, cur, wr, wc, fr, fq, rq);
        if (!has_next) break;
#pragma unroll
        for (int a = 0; a < 2; ++a)
#pragma unroll
            for (int b = 0; b < 2; ++b)
#pragma unroll
                for (int m = 0; m < 4; ++m)
#pragma unroll
                    for (int n = 0; n < 2; ++n) acc[a][b][m][n] = (f32x4){0.f, 0.f, 0.f, 0.f};
        cur = nxt; cA = nA; cB = nB; ++ui;
        E.pre(cur, wr, fr, rq);
        if (wr == 1) PG8_BAR;
    }
    PG8_WAIT_V(0);
    PG8_BAR;
#undef KOA
#undef KOB
#undef PG8_SA
#undef PG8_SB
#undef PG8_STAGE
#undef PG8_LDA
#undef PG8_LDB
#undef PG8_MMA
#undef PG8_WAIT_V
#undef PG8_WAIT_L
#undef PG8_BAR
#undef PG8_SCHED
}
}

namespace att {
#define KSWZ(row, colB) ((row) * 256 + ((colB) ^ (((row) & 15) << 4)))
#define SBAR() __builtin_amdgcn_sched_barrier(0)
__device__ __forceinline__ int crow(int r, int hi) { return (r & 3) + 8 * (r >> 2) + 4 * hi; }
__device__ __forceinline__ unsigned dma_k_off(int i, int ld, int wid, int lane) { const int chunk = (i * 8 + wid) * 64 + lane, row = chunk >> 4, cg = (chunk & 15) ^ (row & 15); return (unsigned)(row * ld + cg * 8) * 2u; }
__device__ __forceinline__ void glds16(const void* sbase, unsigned voff, unsigned lds_dst) {
    unsigned keep;
    asm volatile("s_mov_b32 %0, m0\n\ts_mov_b32 m0, %3\n\ts_nop 0\n\tglobal_load_lds_dwordx4 %1, %2\n\ts_mov_b32 m0, %0" : "=&s"(keep) : "v"(voff), "s"(sbase), "s"(lds_dst) : "memory");
}
__device__ __forceinline__ void glds_tile(const void* k0b, const void* k1b, const void* vb, unsigned k0o, unsigned k1o, unsigned v0, unsigned v1, unsigned v2, unsigned v3, unsigned lds_dst) {
    unsigned keep;
    asm volatile("s_mov_b32 %0, m0\n\t"
                 "s_mov_b32 m0, %10\n\ts_nop 0\n\tglobal_load_lds_dwordx4 %1, %7\n\t"
                 "s_add_u32 m0, m0, 0x2000\n\ts_nop 0\n\tglobal_load_lds_dwordx4 %2, %7\n\t"
                 "s_add_u32 m0, m0, 0x2000\n\ts_nop 0\n\tglobal_load_lds_dwordx4 %1, %8\n\t"
                 "s_add_u32 m0, m0, 0x2000\n\ts_nop 0\n\tglobal_load_lds_dwordx4 %2, %8\n\t"
                 "s_add_u32 m0, m0, 0x2000\n\ts_nop 0\n\tglobal_load_lds_dwordx4 %3, %9\n\t"
                 "s_add_u32 m0, m0, 0x2000\n\ts_nop 0\n\tglobal_load_lds_dwordx4 %4, %9\n\t"
                 "s_add_u32 m0, m0, 0x2000\n\ts_nop 0\n\tglobal_load_lds_dwordx4 %5, %9\n\t"
                 "s_add_u32 m0, m0, 0x2000\n\ts_nop 0\n\tglobal_load_lds_dwordx4 %6, %9\n\t"
                 "s_mov_b32 m0, %0"
                 : "=&s"(keep) : "v"(k0o), "v"(k1o), "v"(v0), "v"(v1), "v"(v2), "v"(v3), "s"(k0b), "s"(k1b), "s"(vb), "s"(lds_dst) : "memory", "scc");
}
__device__ __forceinline__ void dma_k(LAS unsigned char* lds, unsigned dst, const bf16_t* src, unsigned off0, unsigned off1, int wid) {
    const unsigned l0 = (unsigned)(uintptr_t)lds + dst + (unsigned)wid * 1024u;
    glds16(src, off0, l0); glds16(src, off1, l0 + 8192u);
}
__device__ __forceinline__ unsigned dma_v_off(int i, int ld, int wid, int lane) {
    const int o = ((i * 8 + wid) * 64 + lane) * 16, sub = o >> 9, kk = (sub >> 3) * 8 + ((o & 511) >> 6), col = (sub & 7) * 32 + ((o & 63) >> 1);
    const int key = (kk & ~0xC) | ((kk & 4) << 1) | ((kk & 8) >> 1); return (unsigned)(key * ld + col) * 2u;
}
__device__ __forceinline__ void dma_v(LAS unsigned char* lds, unsigned dst, const bf16_t* src, const unsigned (&off)[4], int wid) {
    const unsigned l0 = (unsigned)(uintptr_t)lds + dst + (unsigned)wid * 1024u;
#pragma unroll
    for (int i = 0; i < 4; ++i) glds16(src, off[i], l0 + (unsigned)i * 8192u);
}
__device__ __forceinline__ int v_rd_base(int lane) { return ((lane & 3) << 3) | (((lane >> 2) & 3) << 6) | (((lane >> 4) & 1) << 5) | (((lane >> 5) & 1) << 8); }
constexpr int v_rd_off(int d0, int ks, int half) { return d0 * 512 + ks * 8192 + half * 4096; }
template <int OFF> __device__ __forceinline__ s16x4 tr_read(int vb) {
    s16x4 r; asm volatile("ds_read_b64_tr_b16 %0, %1 offset:%2" : "=&v"(r) : "v"(vb), "i"(OFF) : "memory"); return r;
}
template <int D0> __device__ __forceinline__ void pv_one(f32x16& od, int vb, bf16x8 pa0, bf16x8 pa1, bf16x8 pa2, bf16x8 pa3) {
    const s16x4 l0 = tr_read<v_rd_off(D0, 0, 0)>(vb), h0 = tr_read<v_rd_off(D0, 0, 1)>(vb), l1 = tr_read<v_rd_off(D0, 1, 0)>(vb), h1 = tr_read<v_rd_off(D0, 1, 1)>(vb);
    const s16x4 l2 = tr_read<v_rd_off(D0, 2, 0)>(vb), h2 = tr_read<v_rd_off(D0, 2, 1)>(vb), l3 = tr_read<v_rd_off(D0, 3, 0)>(vb), h3 = tr_read<v_rd_off(D0, 3, 1)>(vb);
    asm volatile("s_waitcnt lgkmcnt(0)" ::: "memory"); SBAR();
#define PK(L, H) (bf16x8){L[0], L[1], L[2], L[3], H[0], H[1], H[2], H[3]}
    od = __builtin_amdgcn_mfma_f32_32x32x16_bf16(pa0, PK(l0, h0), od, 0, 0, 0);
    od = __builtin_amdgcn_mfma_f32_32x32x16_bf16(pa1, PK(l1, h1), od, 0, 0, 0);
    od = __builtin_amdgcn_mfma_f32_32x32x16_bf16(pa2, PK(l2, h2), od, 0, 0, 0);
    od = __builtin_amdgcn_mfma_f32_32x32x16_bf16(pa3, PK(l3, h3), od, 0, 0, 0);
#undef PK
}
__device__ __forceinline__ void pv_all(f32x16 (&o)[8], int vb, bf16x8 pa0, bf16x8 pa1, bf16x8 pa2, bf16x8 pa3) {
    pv_one<0>(o[0], vb, pa0, pa1, pa2, pa3); pv_one<1>(o[1], vb, pa0, pa1, pa2, pa3); pv_one<2>(o[2], vb, pa0, pa1, pa2, pa3); pv_one<3>(o[3], vb, pa0, pa1, pa2, pa3);
    pv_one<4>(o[4], vb, pa0, pa1, pa2, pa3); pv_one<5>(o[5], vb, pa0, pa1, pa2, pa3); pv_one<6>(o[6], vb, pa0, pa1, pa2, pa3); pv_one<7>(o[7], vb, pa0, pa1, pa2, pa3);
}
__device__ __forceinline__ void qkt_acc(f32x16& p0, f32x16& p1, const LAS unsigned char* Ks, const bf16x8 (&qr)[8], int r32, int hi) {
#pragma unroll
    for (int d0 = 0; d0 < 8; ++d0) { const int cb = (d0 * 16 + hi * 8) * 2;
        const bf16x8 b0 = *(const LAS bf16x8*)(Ks + KSWZ(r32, cb));
        const bf16x8 b1 = *(const LAS bf16x8*)(Ks + KSWZ(32 + r32, cb));
        p0 = __builtin_amdgcn_mfma_f32_32x32x16_bf16(b0, qr[d0], p0, 0, 0, 0);
        p1 = __builtin_amdgcn_mfma_f32_32x32x16_bf16(b1, qr[d0], p1, 0, 0, 0); }
}
#define PK4(P, BASE, OUT) do { unsigned a0 = cvt_pk_bf16(P[BASE + 0], P[BASE + 1]), a1 = cvt_pk_bf16(P[BASE + 2], P[BASE + 3]);   \
    unsigned b0 = cvt_pk_bf16(P[BASE + 4], P[BASE + 5]), b1 = cvt_pk_bf16(P[BASE + 6], P[BASE + 7]);                              \
    auto r0 = __builtin_amdgcn_permlane32_swap(a0, b0, false, false); auto r1 = __builtin_amdgcn_permlane32_swap(a1, b1, false, false); \
    u32x4 w = {r0[0], r1[0], r0[1], r1[1]}; OUT = *reinterpret_cast<bf16x8*>(&w); } while (0)
__device__ __forceinline__ float half_max(float v) { auto rr = __builtin_amdgcn_permlane32_swap(__float_as_uint(v), __float_as_uint(v), false, false); return fmaxf(__uint_as_float(rr[0]), __uint_as_float(rr[1])); }
__device__ __forceinline__ float half_sum(float v) { auto rr = __builtin_amdgcn_permlane32_swap(__float_as_uint(v), __float_as_uint(v), false, false); return __uint_as_float(rr[0]) + __uint_as_float(rr[1]); }

struct VFrag { s16x4 l0, h0, l1, h1; };
template <int D0, int HALF> __device__ __forceinline__ void v_issue(VFrag& f, int vb) {
    f.l0 = tr_read<v_rd_off(D0, 2 * HALF, 0)>(vb); f.h0 = tr_read<v_rd_off(D0, 2 * HALF, 1)>(vb); f.l1 = tr_read<v_rd_off(D0, 2 * HALF + 1, 0)>(vb); f.h1 = tr_read<v_rd_off(D0, 2 * HALF + 1, 1)>(vb);
}
#define PKV(L, H) (bf16x8){L[0], L[1], L[2], L[3], H[0], H[1], H[2], H[3]}
template <int D0, int HALF> __device__ __forceinline__ void pv_step(f32x16 (&o)[8], VFrag& cur, VFrag& nxt, int vb, bf16x8 pa0, bf16x8 pa1) {
    if constexpr (D0 < 7) { v_issue<D0 + 1, HALF>(nxt, vb); asm volatile("s_waitcnt lgkmcnt(4)" ::: "memory"); }
    else asm volatile("s_waitcnt lgkmcnt(0)" ::: "memory");
    SBAR();
    o[D0] = __builtin_amdgcn_mfma_f32_32x32x16_bf16(pa0, PKV(cur.l0, cur.h0), o[D0], 0, 0, 0);
    o[D0] = __builtin_amdgcn_mfma_f32_32x32x16_bf16(pa1, PKV(cur.l1, cur.h1), o[D0], 0, 0, 0);
    SBAR();
}
template <int HALF> __device__ __forceinline__ void pv_half(f32x16 (&o)[8], VFrag& f0, int vb, bf16x8 pa0, bf16x8 pa1) {
    VFrag f1;
    pv_step<0, HALF>(o, f0, f1, vb, pa0, pa1); pv_step<1, HALF>(o, f1, f0, vb, pa0, pa1); pv_step<2, HALF>(o, f0, f1, vb, pa0, pa1); pv_step<3, HALF>(o, f1, f0, vb, pa0, pa1);
    pv_step<4, HALF>(o, f0, f1, vb, pa0, pa1); pv_step<5, HALF>(o, f1, f0, vb, pa0, pa1); pv_step<6, HALF>(o, f0, f1, vb, pa0, pa1); pv_step<7, HALF>(o, f1, f0, vb, pa0, pa1);
}
struct DiffArgs { const bf16_t* Q; const bf16_t* K; const bf16_t* V; const bf16_t* SZ; bf16_t* YG; const float* subln_g; float lam, lam_scale; };
__device__ __forceinline__ void diff_tile(f32x16 (&o)[8], const LAS unsigned char* Ks, int vb, const bf16x8 (&qr)[8], LAS float* wsc,
                                          float& m_reg, float& l_reg, float slC, float C, int lim0  , bool diag, int r32, int hi) {
    f32x16 p0 = (f32x16){}, p1 = (f32x16){};
    {
        bf16x8 ka[2], kb[2];
        ka[0] = *(const LAS bf16x8*)(Ks + KSWZ(r32, (hi * 8) * 2)); kb[0] = *(const LAS bf16x8*)(Ks + KSWZ(32 + r32, (hi * 8) * 2));
#pragma unroll
        for (int d0 = 0; d0 < 8; ++d0) {
            if (d0 < 7) { const int cb = ((d0 + 1) * 16 + hi * 8) * 2;
                ka[(d0 + 1) & 1] = *(const LAS bf16x8*)(Ks + KSWZ(r32, cb)); kb[(d0 + 1) & 1] = *(const LAS bf16x8*)(Ks + KSWZ(32 + r32, cb)); }
            SBAR();
            p0 = __builtin_amdgcn_mfma_f32_32x32x16_bf16(ka[d0 & 1], qr[d0], p0, 0, 0, 0);
            p1 = __builtin_amdgcn_mfma_f32_32x32x16_bf16(kb[d0 & 1], qr[d0], p1, 0, 0, 0);
            SBAR(); }
    }
    VFrag vf0; v_issue<0, 0>(vf0, vb);
    if (diag) {
#pragma unroll
        for (int r = 0; r < 16; ++r) { const int kp = (r & 3) + 8 * (r >> 2); if (kp > lim0) p0[r] = -INFINITY; if (kp + 32 > lim0) p1[r] = -INFINITY; } }
    float pmax = p0[0];
#pragma unroll
    for (int r = 1; r < 16; ++r) pmax = fmaxf(pmax, p0[r]);
#pragma unroll
    for (int r = 0; r < 16; ++r) pmax = fmaxf(pmax, p1[r]);
    pmax = half_max(pmax) * C;
    float alpha = 1.f;
    if (!__all(pmax - m_reg <= 6.0f)) { const float mn = fmaxf(m_reg, pmax); alpha = __builtin_amdgcn_exp2f(m_reg - mn); m_reg = mn; }
    const float kb0 = -fmaf(slC, (float)lim0, m_reg), kb1 = fmaf(slC, 32.0f, kb0);
    float ps0 = 0.f, ps1 = 0.f;
#pragma unroll
    for (int r = 0; r < 16; ++r) { const float kpf = (float)((r & 3) + 8 * (r >> 2));
        p0[r] = __builtin_amdgcn_exp2f(fmaf(p0[r], C, fmaf(kpf, slC, kb0))); ps0 += p0[r];
        p1[r] = __builtin_amdgcn_exp2f(fmaf(p1[r], C, fmaf(kpf, slC, kb1))); ps1 += p1[r]; }
    const float ps = half_sum(ps0 + ps1); l_reg = l_reg * alpha + ps;
    bf16x8 pa0, pa1, pa2, pa3; PK4(p0, 0, pa0); PK4(p0, 8, pa1); PK4(p1, 0, pa2); PK4(p1, 8, pa3);
    if (__any(alpha < 1.f)) { if (hi == 0) wsc[r32] = alpha; asm volatile("s_waitcnt lgkmcnt(0)" ::: "memory");
#pragma unroll
        for (int r = 0; r < 16; ++r) { const float a = wsc[crow(r, hi)];
#pragma unroll
            for (int d = 0; d < 8; ++d) o[d][r] *= a; } }
    SBAR();
    pv_half<0>(o, vf0, vb, pa0, pa1);
    VFrag vf1; v_issue<0, 1>(vf1, vb); SBAR();
    pv_half<1>(o, vf1, vb, pa2, pa3);
}
__device__ __forceinline__ void diff_unit(LAS unsigned char* lds, LAS float* wsc_all, const DiffArgs& A, int b, int h, int qb, int rev, int wid, int lane) {
    asm volatile("" : "+v"(lane));
    LAS float* wsc = wsc_all + wid * 64;
    const int r32 = lane & 31, hi = lane >> 5, map = wid >> 2, w4 = wid & 3;
    const int q0 = qb * 128, wrow0 = q0 + 32 * w4;
    const size_t rowb = (size_t)b * SEQ;
    const float slope = (h < 16) ? __builtin_amdgcn_exp2f(-0.5f * (float)(h + 1)) : __builtin_amdgcn_exp2f(-0.25f * (float)(2 * (h - 16) + 1));
    const float C = 0.08838834764831845f * LOG2E, slC = slope * LOG2E;
    const bf16_t* K0 = A.K + (((size_t)(b * 8) * NCT6 + h) << 16); const bf16_t* Vb = A.V + (((size_t)(b * 8) * NCT6 + h) << 16);
#define TOFF(jt_) ((((size_t)((jt_) >> 2) * NCT6) << 16) + (size_t)(((jt_) & 3) * 64 * 256))
    const unsigned ko0 = dma_k_off(0, 256, wid, lane), ko1 = ko0 + 16384u;
    unsigned vo[4]; vo[0] = dma_v_off(0, 256, wid, lane);
#pragma unroll
    for (int i = 1; i < 4; ++i) vo[i] = vo[0] + (unsigned)i * 8192u;
    const int NT = 2 * qb + 2;
    const int vbase = (int)(unsigned)(uintptr_t)(lds) + v_rd_base(lane);
    { const size_t ro = TOFF(rev ? NT - 1 : 0); glds_tile(K0 + ro, K0 + 128 + ro, Vb + ro, ko0, ko1, vo[0], vo[1], vo[2], vo[3], (unsigned)(uintptr_t)lds + (unsigned)wid * 1024u); }
    bf16x8 qr[8];
    { const bf16_t* Qw = A.Q + blk((int)rowb + wrow0 + r32, h * 256 + map * 128 + hi * 8, NCT6);
#pragma unroll
      for (int d0 = 0; d0 < 8; ++d0) qr[d0] = *(const bf16x8*)(Qw + d0 * 16); }
    asm volatile("" :: "v"(qr[0]), "v"(qr[1]), "v"(qr[2]), "v"(qr[3]), "v"(qr[4]), "v"(qr[5]), "v"(qr[6]), "v"(qr[7]));
    float m_reg = -1e30f, l_reg = 0.f; f32x16 o[8];
#pragma unroll
    for (int d = 0; d < 8; ++d) o[d] = (f32x16){};
    for (int st = 0; st < NT; ++st) {
        const int jt = rev ? NT - 1 - st : st; const unsigned buf = (unsigned)(st & 1) * 65536u;
        asm volatile("s_waitcnt vmcnt(0)" ::: "memory"); __builtin_amdgcn_s_barrier(); asm volatile("" ::: "memory");
        if (st + 1 < NT) { const unsigned nb = 65536u - buf; const size_t ro = TOFF(rev ? jt - 1 : jt + 1);
            int ln = lane; asm volatile("" : "+v"(ln));
            const unsigned k0o = dma_k_off(0, 256, wid, ln), k1o = k0o + 16384u; unsigned v2[4]; v2[0] = dma_v_off(0, 256, wid, ln);
#pragma unroll
            for (int i = 1; i < 4; ++i) v2[i] = v2[0] + (unsigned)i * 8192u;
            glds_tile(K0 + ro, K0 + 128 + ro, Vb + ro, k0o, k1o, v2[0], v2[1], v2[2], v2[3], (unsigned)(uintptr_t)lds + nb + (unsigned)wid * 1024u);
        }
        const LAS unsigned char* Ks = lds + buf + (unsigned)map * 16384u; const int vb = vbase + (int)buf + 32768;
        const int lim0 = wrow0 + r32 - 64 * jt - 4 * hi;
        if (64 * jt <= wrow0 + 31)
            diff_tile(o, Ks, vb, qr, wsc, m_reg, l_reg, slC, C, lim0, 64 * jt + 63 > wrow0, r32, hi);
    }
    if (hi == 0) wsc[32 + r32] = l_reg;
    asm volatile("s_waitcnt lgkmcnt(0)" ::: "memory");
    float rli[16];
#pragma unroll
    for (int r = 0; r < 16; r += 4) { const f32x4 l4 = *(const LAS f32x4*)(wsc + 32 + 8 * (r >> 2) + 4 * hi);
#pragma unroll
        for (int e = 0; e < 4; ++e) rli[r + e] = __builtin_amdgcn_rcpf(l4[e]); }
    asm volatile("s_waitcnt lgkmcnt(0)" ::: "memory"); __builtin_amdgcn_s_barrier(); asm volatile("" ::: "memory");
    LAS f32x4* Xo = (LAS f32x4*)lds + (size_t)(w4 * 2 + map) * 1024 + lane;
    const LAS f32x4* Xi = (const LAS f32x4*)lds + (size_t)(w4 * 2 + (map ^ 1)) * 1024 + lane;
    float v[4][16];
    if (map == 0) {
#pragma unroll
        for (int dd = 0; dd < 4; ++dd)
#pragma unroll
            for (int r = 0; r < 16; r += 4) { Xo[(dd * 4 + (r >> 2)) * 64] = (f32x4){o[4 + dd][r] * rli[r], o[4 + dd][r + 1] * rli[r + 1], o[4 + dd][r + 2] * rli[r + 2], o[4 + dd][r + 3] * rli[r + 3]};
#pragma unroll
                for (int e = 0; e < 4; ++e) v[dd][r + e] = o[dd][r + e] * rli[r + e]; }
    } else {
#pragma unroll
        for (int dd = 0; dd < 4; ++dd)
#pragma unroll
            for (int r = 0; r < 16; r += 4) { Xo[(dd * 4 + (r >> 2)) * 64] = (f32x4){o[dd][r] * rli[r], o[dd][r + 1] * rli[r + 1], o[dd][r + 2] * rli[r + 2], o[dd][r + 3] * rli[r + 3]};
#pragma unroll
                for (int e = 0; e < 4; ++e) v[dd][r + e] = o[4 + dd][r + e] * rli[r + e]; }
    }
    asm volatile("s_waitcnt lgkmcnt(0)" ::: "memory"); __builtin_amdgcn_s_barrier(); asm volatile("" ::: "memory");
    const int cbase = h * 256 + map * 128, c8 = (lane & 15) * 8, rq = lane >> 4;
    u32x4 gz[8]; float gsub[4];
#pragma unroll
    for (int i = 0; i < 8; ++i) gz[i] = *(const u32x4*)(A.SZ + blk((int)rowb + wrow0 + 4 * i + rq, cbase + c8, NCT8));
#pragma unroll
    for (int dd = 0; dd < 4; ++dd) gsub[dd] = A.subln_g[map * 128 + dd * 32 + r32];
    float ss[16];
#pragma unroll
    for (int r = 0; r < 16; ++r) ss[r] = 0.f;
#pragma unroll
    for (int dd = 0; dd < 4; ++dd)
#pragma unroll
        for (int r = 0; r < 16; r += 4) { const f32x4 x4 = Xi[(dd * 4 + (r >> 2)) * 64];
#pragma unroll
            for (int e = 0; e < 4; ++e) { const float x = x4[e]; const float y = map ? (x - A.lam * v[dd][r + e]) : (v[dd][r + e] - A.lam * x); v[dd][r + e] = y; ss[r + e] += y * y; } }
#define ROR_ADD(X, N) X += __builtin_bit_cast(float, __builtin_amdgcn_update_dpp(0, __builtin_bit_cast(int, X), 0x120 | (N), 0xf, 0xf, false))
#pragma unroll
    for (int r = 0; r < 16; ++r) { float sq = ss[r];
        ROR_ADD(sq, 8); ROR_ADD(sq, 4); ROR_ADD(sq, 2); ROR_ADD(sq, 1);
        sq += __shfl_xor(sq, 16);
        ss[r] = sq; }
#undef ROR_ADD
    if (r32 == 0) {
#pragma unroll
        for (int r = 0; r < 16; r += 4) *(LAS f32x4*)(wsc + 32 + hi * 16 + r) = (f32x4){ss[r], ss[r + 1], ss[r + 2], ss[r + 3]}; }
    asm volatile("s_waitcnt lgkmcnt(0)" ::: "memory"); __builtin_amdgcn_s_barrier(); asm volatile("" ::: "memory");
    { const LAS float* pw = wsc_all + (wid ^ 4) * 64 + 32 + hi * 16;
#pragma unroll
      for (int r = 0; r < 16; r += 4) { const f32x4 p4 = *(const LAS f32x4*)(pw + r);
#pragma unroll
          for (int e = 0; e < 4; ++e) ss[r + e] = __builtin_amdgcn_rsqf((ss[r + e] + p4[e]) * (1.0f / 256.0f) + SUBLN_EPS) * A.lam_scale; } }
    LAS float* T = (LAS float*)lds + wid * 4096;
    { LAS float* Te = T + (4 * hi) * 128 + r32 + hi * 32; LAS float* To = T + (4 * hi) * 128 + r32 - hi * 32;
#pragma unroll
      for (int dd = 0; dd < 4; ++dd)
#pragma unroll
          for (int r = 0; r < 16; ++r) ((dd & 1) ? To : Te)[((r & 3) + 8 * (r >> 2)) * 128 + dd * 32] = v[dd][r] * ss[r] * gsub[dd]; }
    asm volatile("s_waitcnt lgkmcnt(0)" ::: "memory");
    f32x4 ya[8], yb[8];
#pragma unroll
    for (int i = 0; i < 8; ++i) { const LAS float* sp = T + (4 * i + rq) * 128 + (c8 ^ ((i & 1) * 32)); ya[i] = *(const LAS f32x4*)sp; yb[i] = *(const LAS f32x4*)(sp + 4); }
    asm volatile("s_waitcnt lgkmcnt(0)" ::: "memory"); __builtin_amdgcn_s_barrier(); asm volatile("" ::: "memory");
#pragma unroll
    for (int i = 0; i < 8; ++i) { u32x4 w;
        w.x = cvt_pk_bf16(ya[i].x * bf_lo(gz[i].x), ya[i].y * bf_hi(gz[i].x)); w.y = cvt_pk_bf16(ya[i].z * bf_lo(gz[i].y), ya[i].w * bf_hi(gz[i].y));
        w.z = cvt_pk_bf16(yb[i].x * bf_lo(gz[i].z), yb[i].y * bf_hi(gz[i].z)); w.w = cvt_pk_bf16(yb[i].z * bf_lo(gz[i].w), yb[i].w * bf_hi(gz[i].w));
        *(u32x4*)(A.YG + blk((int)rowb + wrow0 + 4 * i + rq, cbase + c8, NCT8)) = w; }
}

#undef TOFF
struct MemArgs { const bf16_t* QM; const bf16_t* KV; const bf16_t* SZ; bf16_t* YG; };
__device__ __forceinline__ void mem_unit(LAS unsigned char* lds, LAS float* wsc_all, const MemArgs& A, int b, int h, int qb, int half, int wid, int lane) {
    asm volatile("" : "+v"(lane));
    LAS float* wsc = wsc_all + wid * 64;
    const int r32 = lane & 31, hi = lane >> 5;
    const size_t qrow = (size_t)b * SEQ + qb * 256 + wid * 32;
    const bf16_t* Kb = A.KV + (size_t)b * MEMLEN * LD4 + h * MHD; const bf16_t* Vb = A.KV + (size_t)b * MEMLEN * LD4 + DMEMB + h * MHD + half * 256;
    const float C = 0.04419417382415922f * LOG2E;
    f32x16 p[8];
#pragma unroll
    for (int i = 0; i < 8; ++i) p[i] = (f32x16){};
    bf16x8 qr[8];
    asm volatile("" ::: "memory"); __builtin_amdgcn_s_barrier(); asm volatile("" ::: "memory");
    { int ln = lane; asm volatile("" : "+v"(ln)); const unsigned ko0 = dma_k_off(0, LD4, wid, ln), ko1 = dma_k_off(1, LD4, wid, ln);
#pragma unroll
      for (int kt = 0; kt < 4; ++kt) dma_k(lds, (unsigned)kt * 16384u, Kb + (size_t)kt * 64 * LD4, ko0, ko1, wid); }
    const bf16_t* Qw = A.QM + blk((int)qrow + r32, h * MHD + hi * 8, NCT2);
#pragma unroll
    for (int d0 = 0; d0 < 8; ++d0) qr[d0] = *(const bf16x8*)(Qw + d0 * 16);
#pragma unroll
    for (int c = 0; c < 4; ++c) {
        asm volatile("s_waitcnt vmcnt(0)" ::: "memory");
        asm volatile("" : "+v"(qr[0]), "+v"(qr[1]), "+v"(qr[2]), "+v"(qr[3]), "+v"(qr[4]), "+v"(qr[5]), "+v"(qr[6]), "+v"(qr[7]));
        __builtin_amdgcn_s_barrier(); asm volatile("" ::: "memory");
        if (c < 3) { int ln = lane; asm volatile("" : "+v"(ln)); const unsigned ko0 = dma_k_off(0, LD4, wid, ln), ko1 = dma_k_off(1, LD4, wid, ln);
#pragma unroll
            for (int kt = 0; kt < 4; ++kt) dma_k(lds, (unsigned)((c + 1) & 1) * 65536u + (unsigned)kt * 16384u, Kb + (size_t)kt * 64 * LD4 + (c + 1) * 128, ko0, ko1, wid);
        }
        const LAS unsigned char* Kc = lds + (c & 1) * 65536;
#pragma unroll
        for (int d0 = 0; d0 < 8; ++d0) { const int cb = (d0 * 16 + hi * 8) * 2;
#pragma unroll
            for (int kt = 0; kt < 4; ++kt) {
                const bf16x8 b0 = *(const LAS bf16x8*)(Kc + kt * 16384 + KSWZ(r32, cb));
                const bf16x8 b1 = *(const LAS bf16x8*)(Kc + kt * 16384 + KSWZ(32 + r32, cb));
                p[2 * kt] = __builtin_amdgcn_mfma_f32_32x32x16_bf16(b0, qr[d0], p[2 * kt], 0, 0, 0);
                p[2 * kt + 1] = __builtin_amdgcn_mfma_f32_32x32x16_bf16(b1, qr[d0], p[2 * kt + 1], 0, 0, 0); }
            SBAR();
            if (c < 3) qr[d0] = *(const bf16x8*)(A.QM + blk((int)qrow + r32, h * MHD + (c + 1) * 128 + hi * 8, NCT2) + d0 * 16);
            SBAR(); }
    }
    asm volatile("" ::: "memory"); __builtin_amdgcn_s_barrier(); asm volatile("" ::: "memory");
    { int ln = lane; asm volatile("" : "+v"(ln)); unsigned vo[4];
#pragma unroll
      for (int i = 0; i < 4; ++i) vo[i] = dma_v_off(i, LD4, wid, ln);
#pragma unroll
      for (int kt = 0; kt < 4; ++kt) dma_v(lds, (unsigned)kt * 32768u, Vb + (size_t)kt * 64 * LD4, vo, wid); }
    float pmax = p[0][0];
#pragma unroll
    for (int i = 0; i < 8; ++i)
#pragma unroll
        for (int r = 0; r < 16; ++r) pmax = fmaxf(pmax, p[i][r]);
    pmax = half_max(pmax);
    const float mn = pmax * C; float ps = 0.f;
#pragma unroll
    for (int i = 0; i < 8; ++i)
#pragma unroll
        for (int r = 0; r < 16; ++r) { p[i][r] = __builtin_amdgcn_exp2f(fmaf(p[i][r], C, -mn)); ps += p[i][r]; }
    ps = half_sum(ps);
    bf16x8 pa[4][4];
#pragma unroll
    for (int kt = 0; kt < 4; ++kt) { PK4(p[2 * kt], 0, pa[kt][0]); PK4(p[2 * kt], 8, pa[kt][1]); PK4(p[2 * kt + 1], 0, pa[kt][2]); PK4(p[2 * kt + 1], 8, pa[kt][3]); }
    f32x16 o[8];
#pragma unroll
    for (int d = 0; d < 8; ++d) o[d] = (f32x16){};
    const int vbase = (int)(unsigned)(uintptr_t)(lds) + v_rd_base(lane);
    asm volatile("s_waitcnt vmcnt(0)" ::: "memory"); __builtin_amdgcn_s_barrier(); asm volatile("" ::: "memory");
#pragma unroll
    for (int kt = 0; kt < 4; ++kt) pv_all(o, vbase + kt * 32768, pa[kt][0], pa[kt][1], pa[kt][2], pa[kt][3]);
    if (hi == 0) wsc[32 + r32] = ps;
    asm volatile("s_waitcnt lgkmcnt(0)" ::: "memory");
    float rli[16];
#pragma unroll
    for (int r = 0; r < 16; r += 4) { const f32x4 l4 = *(const LAS f32x4*)(wsc + 32 + 8 * (r >> 2) + 4 * hi);
#pragma unroll
        for (int e = 0; e < 4; ++e) rli[r + e] = __builtin_amdgcn_rcpf(l4[e]); }
    asm volatile("" ::: "memory"); __builtin_amdgcn_s_barrier(); asm volatile("" ::: "memory");
    const int c8 = (lane & 15) * 8, rq = lane >> 4;
    LAS float* T = (LAS float*)lds + wid * 4096;
    LAS float* Te = T + (4 * hi) * 128 + r32 + hi * 32; LAS float* To = T + (4 * hi) * 128 + r32 - hi * 32;
#pragma unroll
    for (int dq = 0; dq < 8; dq += 4) {
        const int cbase = DMIX + h * MHD + half * 256 + dq * 32;
        u32x4 gz[8];
#pragma unroll
        for (int i = 0; i < 8; ++i) gz[i] = *(const u32x4*)(A.SZ + blk((int)qrow + 4 * i + rq, cbase + c8, NCT8));
#pragma unroll
        for (int dd = 0; dd < 4; ++dd)
#pragma unroll
            for (int r = 0; r < 16; ++r) ((dd & 1) ? To : Te)[((r & 3) + 8 * (r >> 2)) * 128 + dd * 32] = o[dq + dd][r] * rli[r];
        asm volatile("s_waitcnt lgkmcnt(0)" ::: "memory");
        f32x4 ya[8], yb[8];
#pragma unroll
        for (int i = 0; i < 8; ++i) { const LAS float* sp = T + (4 * i + rq) * 128 + (c8 ^ ((i & 1) * 32)); ya[i] = *(const LAS f32x4*)sp; yb[i] = *(const LAS f32x4*)(sp + 4); }
        asm volatile("s_waitcnt lgkmcnt(0)" ::: "memory");
#pragma unroll
        for (int i = 0; i < 8; ++i) { u32x4 w;
            w.x = cvt_pk_bf16(ya[i].x * bf_lo(gz[i].x), ya[i].y * bf_hi(gz[i].x)); w.y = cvt_pk_bf16(ya[i].z * bf_lo(gz[i].y), ya[i].w * bf_hi(gz[i].y));
            w.z = cvt_pk_bf16(yb[i].x * bf_lo(gz[i].z), yb[i].y * bf_hi(gz[i].z)); w.w = cvt_pk_bf16(yb[i].z * bf_lo(gz[i].w), yb[i].w * bf_hi(gz[i].w));
            *(u32x4*)(A.YG + blk((int)qrow + 4 * i + rq, cbase + c8, NCT8)) = w; }
    }
    asm volatile("s_waitcnt lgkmcnt(0)" ::: "memory"); __builtin_amdgcn_s_barrier(); asm volatile("" ::: "memory");
}
#undef PK4
}

constexpr size_t MiB = 1u << 20;
constexpr size_t ws_up(size_t x) { return (x + MiB - 1) / MiB * MiB; }
constexpr size_t WS_CTL = 0, CTL_ZERO_BYTES = 1 * MiB;
constexpr size_t WS_WIN0T = 2 * MiB, WS_POOLWT = WS_WIN0T + ws_up((size_t)N0 * LD4 * 2), WS_WKV0T = WS_POOLWT + ws_up((size_t)4 * PGRP * LDP * 2), WS_WKV1T = WS_WKV0T + ws_up((size_t)DM * LD4 * 2);
constexpr size_t WS_WOUT0T = WS_WKV1T + ws_up((size_t)DM * LD4 * 2), WS_WOUT1T = WS_WOUT0T + ws_up((size_t)DM * LD8 * 2), WS_WIN1T = WS_WOUT1T + ws_up((size_t)DM * LD8 * 2);
constexpr size_t WS_H = WS_WIN1T + ws_up((size_t)N1 * LD4 * 2), WS_MN0 = WS_H + ws_up((size_t)M * LD4 * 2), WS_MN1 = WS_MN0 + ws_up((size_t)MROWS * LD4 * 2), WS_KV0 = WS_MN1 + ws_up((size_t)MROWS * LD4 * 2), WS_KV1 = WS_KV0 + ws_up((size_t)MROWS * LD4 * 2);
constexpr size_t WS_U = WS_KV1 + ws_up((size_t)MROWS * LD4 * 2), WS_PL = WS_U + ws_up((size_t)M * LD6 * 2), WS_V = WS_PL + ws_up((size_t)M * LD6 * 2), WS_QM = WS_V + ws_up((size_t)M * LD6 * 2);
constexpr size_t WS_SZ = WS_QM + ws_up((size_t)M * LD2 * 2), WS_YG = WS_SZ + ws_up((size_t)M * LD8 * 2), WS_X1 = WS_YG + ws_up((size_t)M * LD8 * 2), WS_X2 = WS_X1 + (size_t)M * DM * 4, WS_END = WS_X2 + (size_t)M * DM * 4;
static_assert(WS_END <= (size_t)1700 * MiB, "d_ws map");
constexpr int CW_BAR = 4096, CW_QUEUE = 16384, CW_ROWSS = 131072;
constexpr int RING_BYTES = 131072, WSC_OFF = RING_BYTES, MISC_OFF = WSC_OFF + 2048, LDS_BYTES = 147456;
constexpr int NWAVES = 8, NPHASE = 10;

#define XB_TMO      128
#define XB_XCNT(j)  (256  + 64 * (j))
#define XB_XSUB(j)  (1280 + 64 * (j))
#define XB_XGEN(j)  (2304 + 64 * (j))
#define XB_TOP      3328
#define XB_TOPGEN   3392
#define XCD_BAR_WORDS 3456
#define XB_SPIN_CAP (1u << 18)
__device__ __forceinline__ unsigned xb_ld(unsigned* p)              { return __hip_atomic_load(p, __ATOMIC_RELAXED, __HIP_MEMORY_SCOPE_AGENT); }
__device__ __forceinline__ unsigned xb_add(unsigned* p, unsigned v) { return __hip_atomic_fetch_add(p, v, __ATOMIC_RELAXED, __HIP_MEMORY_SCOPE_AGENT); }
__device__ __forceinline__ unsigned xb_xcc_id() { return (unsigned)__builtin_amdgcn_s_getreg((3 << 11) | 20) & 0xFu; }
#define XB_SPIN(cond, bar) do { unsigned _sp = 0; while (cond) { __builtin_amdgcn_s_sleep(1); \
    if ((++_sp & 255u) == 0u) { if (xb_ld(&(bar)[XB_TMO])) break; if (_sp > XB_SPIN_CAP) { atomicAdd(&(bar)[XB_TMO], 1u); break; } } } } while (0)
struct XcdBarrier { unsigned* bar; unsigned x; volatile LAS unsigned* st; };
__device__ __forceinline__ XcdBarrier xcd_barrier_post(unsigned* bar, volatile LAS unsigned* st) {
    XcdBarrier b; b.bar = bar; b.x = xb_xcc_id(); b.st = st;
    if (threadIdx.x == 0) (void)xb_add(&bar[XB_XCNT(b.x)], 1u);
    return b;
}
__device__ __forceinline__ void xcd_barrier_complete(unsigned* bar, unsigned x, unsigned& nloc, unsigned& nx) {
    const unsigned G = gridDim.x * gridDim.y * gridDim.z;
    unsigned sum, cnt, mine, sp = 0u;
    for (;;) {
        sum = 0u; cnt = 0u; mine = 0u;
#pragma unroll
        for (unsigned j = 0; j < 16; ++j) { const unsigned c = xb_ld(&bar[XB_XCNT(j)]); sum += c; cnt += (c > 0u) ? 1u : 0u; mine = (j == x) ? c : mine; }
        if (sum == G) break;
        __builtin_amdgcn_s_sleep(1);
        if ((++sp & 255u) == 0u) { if (xb_ld(&bar[XB_TMO])) break; if (sp > XB_SPIN_CAP) { atomicAdd(&bar[XB_TMO], 1u); break; } }
    }
    nloc = mine > 0u ? mine : 1u; nx = cnt > 0u ? cnt : 1u;
}
__device__ __forceinline__ void xcd_barrier(const XcdBarrier& b) {
    asm volatile("s_waitcnt vmcnt(0)" ::: "memory");
    __syncthreads();
    if (threadIdx.x == 0) {
        unsigned* bar = b.bar;
        __builtin_amdgcn_s_waitcnt(0);
        unsigned nloc = b.st[0], nx = b.st[1];
        if (nloc == 0u) { xcd_barrier_complete(bar, b.x, nloc, nx); b.st[0] = nloc; b.st[1] = nx; }
        const unsigned old = xb_add(&bar[XB_XSUB(b.x)], 1u);
        const unsigned gen = old / nloc;
        if (old + 1u == (gen + 1u) * nloc) {
            __builtin_amdgcn_fence(__ATOMIC_RELEASE, "agent");
            asm volatile("s_waitcnt vmcnt(0)" ::: "memory");
            const unsigned og = xb_add(&bar[XB_TOP], 1u);
            const unsigned tg = og / nx;
            if (og + 1u == (tg + 1u) * nx) xb_add(&bar[XB_TOPGEN], 1u);
            else XB_SPIN(xb_ld(&bar[XB_TOPGEN]) == tg, bar);
            __builtin_amdgcn_fence(__ATOMIC_ACQUIRE, "agent");
            xb_add(&bar[XB_XGEN(b.x)], 1u);
            asm volatile("s_waitcnt vmcnt(0)" ::: "memory");
        } else {
            XB_SPIN(xb_ld(&bar[XB_XGEN(b.x)]) == gen, bar);
            __builtin_amdgcn_fence(__ATOMIC_ACQUIRE, "agent");
            asm volatile("s_waitcnt vmcnt(0)" ::: "memory");
        }
    }
    __syncthreads();
}

__device__ __forceinline__ float wave_sum(float v) {
#pragma unroll
    for (int o = 1; o < 64; o <<= 1) v += __shfl_xor(v, o);
    return v;
}
__device__ __forceinline__ unsigned f2bf(float f) { unsigned u = __builtin_bit_cast(unsigned, f); return (u + 0x7fffu + ((u >> 16) & 1u)) >> 16; }
__device__ __forceinline__ unsigned pk2(float lo, float hi) { return cvt_pk_bf16(lo, hi); }
__device__ __forceinline__ void transpose_item(const float* W, int K, int N, bf16_t* WT, int ldt, LAS float* scr, int item, int lane, const float* rowgain = nullptr) {
    const int nblk = N / 32, kb = item / nblk, nb = item % nblk, k0 = 64 * kb, n0 = 32 * nb;
    float wv[32];
#pragma unroll
    for (int i = 0; i < 32; ++i) wv[i] = W[(size_t)(k0 + 2 * i + (lane >> 5)) * N + n0 + (lane & 31)];
    if (rowgain) {
#pragma unroll
        for (int i = 0; i < 32; ++i) wv[i] *= rowgain[k0 + 2 * i + (lane >> 5)]; }
#pragma unroll
    for (int i = 0; i < 32; ++i) scr[(2 * i + (lane >> 5)) * 33 + (lane & 31)] = wv[i];
    asm volatile("s_waitcnt lgkmcnt(0)" ::: "memory");
    const int c = lane & 7;
#pragma unroll
    for (int j = 0; j < 4; ++j) { const int n = (lane >> 3) + 8 * j; const LAS float* s = scr + (8 * c) * 33 + n;
        u32x4 o; o.x = pk2(s[0 * 33], s[1 * 33]); o.y = pk2(s[2 * 33], s[3 * 33]); o.z = pk2(s[4 * 33], s[5 * 33]); o.w = pk2(s[6 * 33], s[7 * 33]);
        *(u32x4*)(WT + (size_t)(n0 + n) * ldt + k0 + 8 * c) = o; }
    asm volatile("s_waitcnt lgkmcnt(0)" ::: "memory");
}
struct TrDesc { const float* W; bf16_t* WT; const float* gain; int N, ldt, k0, n0, nkt; };
__device__ __forceinline__ void tr_set(TrDesc& d, const float* W, int N, bf16_t* WT, int ldt, int item, const float* gain, int nkt = 0) {
    const int nblk = N / 32, kb = item / nblk, nb = item % nblk; d.W = W; d.WT = WT; d.gain = gain; d.N = N; d.ldt = ldt; d.k0 = 64 * kb; d.n0 = 32 * nb; d.nkt = nkt;
}
__device__ __forceinline__ void tr_load(const TrDesc& d, float (&wv)[32], int lane) {
#pragma unroll
    for (int i = 0; i < 32; ++i) wv[i] = d.W[(size_t)(d.k0 + 2 * i + (lane >> 5)) * d.N + d.n0 + (lane & 31)];
}
__device__ __forceinline__ void tr_finish(const TrDesc& d, float (&wv)[32], LAS float* scr, int lane) {
    if (d.gain) {
#pragma unroll
        for (int i = 0; i < 32; ++i) wv[i] *= d.gain[d.k0 + 2 * i + (lane >> 5)]; }
#pragma unroll
    for (int i = 0; i < 32; ++i) scr[(2 * i + (lane >> 5)) * 33 + (lane & 31)] = wv[i];
    asm volatile("s_waitcnt lgkmcnt(0)" ::: "memory");
    const int c = lane & 7;
#pragma unroll
    for (int j = 0; j < 4; ++j) { const int n = (lane >> 3) + 8 * j; const LAS float* sp = scr + (8 * c) * 33 + n;
        u32x4 o; o.x = pk2(sp[0 * 33], sp[1 * 33]); o.y = pk2(sp[2 * 33], sp[3 * 33]); o.z = pk2(sp[4 * 33], sp[5 * 33]); o.w = pk2(sp[6 * 33], sp[7 * 33]);
        const int nn = d.n0 + n, kk = d.k0 + 8 * c;
        bf16_t* dst = d.nkt ? d.WT + (((size_t)(nn >> 8) * d.nkt + (kk >> 8)) << 16) + ((nn & 255) << 8) + (kk & 255) : d.WT + (size_t)nn * d.ldt + kk;
        *(u32x4*)dst = o; }
    asm volatile("s_waitcnt lgkmcnt(0)" ::: "memory");
}
__device__ __forceinline__ void rms_row_bf16(const float* xrow, const float* g0, bf16_t* o0, const float* g1, bf16_t* o1, int lane) {
    const f32x4* xr = (const f32x4*)xrow + lane; f32x4 v[16]; float s = 0.f;
#pragma unroll
    for (int j = 0; j < 16; ++j) { v[j] = xr[64 * j]; s += (v[j].x * v[j].x + v[j].y * v[j].y) + (v[j].z * v[j].z + v[j].w * v[j].w); }
    const float rs = __builtin_amdgcn_rsqf(wave_sum(s) * (1.0f / DM) + RMS_EPS);
#pragma unroll
    for (int j = 0; j < 16; ++j) { const f32x4 gg = ((const f32x4*)g0)[lane + 64 * j]; const f32x4 y = v[j] * rs * gg;
        u32x2 w; w.x = pk2(y.x, y.y); w.y = pk2(y.z, y.w); ((u32x2*)o0)[lane + 64 * j] = w; }
    if (o1) {
#pragma unroll
        for (int j = 0; j < 16; ++j) { const f32x4 gg = ((const f32x4*)g1)[lane + 64 * j]; const f32x4 y = v[j] * rs * gg;
            u32x2 w; w.x = pk2(y.x, y.y); w.y = pk2(y.z, y.w); ((u32x2*)o1)[lane + 64 * j] = w; }
    }
}
__device__ __forceinline__ void rms_row2_bf16(const float* xa, const float* xb, const float* g0, bf16_t* oa, bf16_t* ob, int lane) {
    const f32x4* xra = (const f32x4*)xa + lane; const f32x4* xrb = (const f32x4*)xb + lane; f32x4 va[16], vb[16]; float sa = 0.f, sb = 0.f;
#pragma unroll
    for (int j = 0; j < 16; ++j) va[j] = xra[64 * j];
#pragma unroll
    for (int j = 0; j < 16; ++j) vb[j] = xrb[64 * j];
#pragma unroll
    for (int j = 0; j < 16; ++j) sa += (va[j].x * va[j].x + va[j].y * va[j].y) + (va[j].z * va[j].z + va[j].w * va[j].w);
#pragma unroll
    for (int j = 0; j < 16; ++j) sb += (vb[j].x * vb[j].x + vb[j].y * vb[j].y) + (vb[j].z * vb[j].z + vb[j].w * vb[j].w);
    const float ra = __builtin_amdgcn_rsqf(wave_sum(sa) * (1.0f / DM) + RMS_EPS), rb = __builtin_amdgcn_rsqf(wave_sum(sb) * (1.0f / DM) + RMS_EPS);
#pragma unroll
    for (int j = 0; j < 16; ++j) { const f32x4 gg = ((const f32x4*)g0)[lane + 64 * j]; const f32x4 ya = va[j] * ra * gg, yb = vb[j] * rb * gg;
        u32x2 w; w.x = pk2(ya.x, ya.y); w.y = pk2(ya.z, ya.w); ((u32x2*)oa)[lane + 64 * j] = w;
        u32x2 z; z.x = pk2(yb.x, yb.y); z.y = pk2(yb.z, yb.w); ((u32x2*)ob)[lane + 64 * j] = z; }
}
__device__ __forceinline__ void rms_row_f32(const float* xrow, const float* g, float* orow, int lane) {
    const f32x4* xr = (const f32x4*)xrow + lane; f32x4 v[16]; float s = 0.f;
#pragma unroll
    for (int j = 0; j < 16; ++j) { v[j] = xr[64 * j]; s += (v[j].x * v[j].x + v[j].y * v[j].y) + (v[j].z * v[j].z + v[j].w * v[j].w); }
    const float rs = __builtin_amdgcn_rsqf(wave_sum(s) * (1.0f / DM) + RMS_EPS);
#pragma unroll
    for (int j = 0; j < 16; ++j) { const f32x4 gg = ((const f32x4*)g)[lane + 64 * j]; ((f32x4*)orow)[lane + 64 * j] = v[j] * rs * gg; }
}
__device__ __forceinline__ void final_row(const bf16_t* xrow, const float* rowss, const float* g, float* orow, int lane) {
    const float rs = __builtin_amdgcn_rsqf(__hip_atomic_load(rowss, __ATOMIC_RELAXED, __HIP_MEMORY_SCOPE_AGENT) * (1.0f / DM) + RMS_EPS);
#pragma unroll
    for (int j = 0; j < 8; ++j) { const u32x4 w = ((const u32x4*)xrow)[lane + 64 * j]; const f32x4 g0 = ((const f32x4*)g)[2 * (lane + 64 * j)], g1 = ((const f32x4*)g)[2 * (lane + 64 * j) + 1];
        ((f32x4*)orow)[2 * (lane + 64 * j)] = (f32x4){bf_lo(w.x), bf_hi(w.x), bf_lo(w.y), bf_hi(w.y)} * rs * g0;
        ((f32x4*)orow)[2 * (lane + 64 * j) + 1] = (f32x4){bf_lo(w.z), bf_hi(w.z), bf_lo(w.w), bf_hi(w.w)} * rs * g1; }
}
__device__ __forceinline__ void final_row2(const bf16_t* xa, const bf16_t* xb, const float* ssa, const float* ssb, const float* g, float* oa, float* ob, int lane) {
    u32x4 wa[8], wb[8];
#pragma unroll
    for (int j = 0; j < 8; ++j) wa[j] = ((const u32x4*)xa)[lane + 64 * j];
#pragma unroll
    for (int j = 0; j < 8; ++j) wb[j] = ((const u32x4*)xb)[lane + 64 * j];
    const float ra = __builtin_amdgcn_rsqf(__hip_atomic_load(ssa, __ATOMIC_RELAXED, __HIP_MEMORY_SCOPE_AGENT) * (1.0f / DM) + RMS_EPS);
    const float rb = __builtin_amdgcn_rsqf(__hip_atomic_load(ssb, __ATOMIC_RELAXED, __HIP_MEMORY_SCOPE_AGENT) * (1.0f / DM) + RMS_EPS);
#pragma unroll
    for (int j = 0; j < 8; ++j) { const f32x4 g0 = ((const f32x4*)g)[2 * (lane + 64 * j)], g1 = ((const f32x4*)g)[2 * (lane + 64 * j) + 1];
        ((f32x4*)oa)[2 * (lane + 64 * j)] = (f32x4){bf_lo(wa[j].x), bf_hi(wa[j].x), bf_lo(wa[j].y), bf_hi(wa[j].y)} * ra * g0;
        ((f32x4*)oa)[2 * (lane + 64 * j) + 1] = (f32x4){bf_lo(wa[j].z), bf_hi(wa[j].z), bf_lo(wa[j].w), bf_hi(wa[j].w)} * ra * g1;
        ((f32x4*)ob)[2 * (lane + 64 * j)] = (f32x4){bf_lo(wb[j].x), bf_hi(wb[j].x), bf_lo(wb[j].y), bf_hi(wb[j].y)} * rb * g0;
        ((f32x4*)ob)[2 * (lane + 64 * j) + 1] = (f32x4){bf_lo(wb[j].z), bf_hi(wb[j].z), bf_lo(wb[j].w), bf_hi(wb[j].w)} * rb * g1; }
}
__device__ __forceinline__ void unpack8(const u32x4 w, float (&f)[8]) { f[0] = bf_lo(w.x); f[1] = bf_hi(w.x); f[2] = bf_lo(w.y); f[3] = bf_hi(w.y); f[4] = bf_lo(w.z); f[5] = bf_hi(w.z); f[6] = bf_lo(w.w); f[7] = bf_hi(w.w); }
#define UB(t_) (ub + (((size_t)((t_) >> 8) * NCT6) << 16) + (size_t)(((t_) & 255) << 8))
template <int W> __device__ __forceinline__ void pool_block(const bf16_t* ub, bf16_t* pb, int t0) {
    constexpr int NR = W - 1 + 16;
    u32x4 row[NR];
    if (t0 == 0) {
#pragma unroll
        for (int i = 0; i < NR; ++i) row[i] = (i >= W - 1) ? *(const u32x4*)UB(i - (W - 1)) : (u32x4){0u, 0u, 0u, 0u};
    } else {
#pragma unroll
        for (int i = 0; i < NR; ++i) row[i] = *(const u32x4*)UB(t0 - (W - 1) + i);
    }
    float s[8];
#pragma unroll
    for (int e = 0; e < 8; ++e) s[e] = 0.f;
#pragma unroll
    for (int i = 0; i < W - 1; ++i) { float f[8]; unpack8(row[i], f);
#pragma unroll
        for (int e = 0; e < 8; ++e) s[e] += f[e]; }
#pragma unroll
    for (int k = 0; k < 16; ++k) { const int t = t0 + k;
        float cur[8]; unpack8(row[W - 1 + k], cur);
        const float inv = 1.0f / (float)((t + 1) < W ? (t + 1) : W);
        float ov[8];
#pragma unroll
        for (int e = 0; e < 8; ++e) { s[e] += cur[e]; ov[e] = s[e] * inv - cur[e]; }
        u32x4 o; o.x = pk2(ov[0], ov[1]); o.y = pk2(ov[2], ov[3]); o.z = pk2(ov[4], ov[5]); o.w = pk2(ov[6], ov[7]);
        *(u32x4*)(pb + (size_t)t * LD6) = o;
        float f[8]; unpack8(row[k], f);
#pragma unroll
        for (int e = 0; e < 8; ++e) s[e] -= f[e]; }
}
__device__ __forceinline__ void pool_items(const bf16_t* U, bf16_t* P, int gw, int ngw, int lane) {
    for (int it = gw; it < NB * 128 * 12; it += ngw) {
        const int cg = it % 12, tc = (it / 12) % 128, b = it / (12 * 128), c0 = cg * 512 + lane * 8, t0 = tc * 16;
        const bf16_t* ub = U + (((size_t)(b * 8) * NCT6 + (c0 >> 8)) << 16) + (c0 & 255); bf16_t* pb = P + (size_t)b * SEQ * LD6 + c0;
        switch (cg / 3) { case 0: pool_block<2>(ub, pb, t0); break; case 1: pool_block<4>(ub, pb, t0); break; case 2: pool_block<8>(ub, pb, t0); break; default: pool_block<16>(ub, pb, t0); break; }
    }
}
#undef UB
struct Args { const float* in[20]; float* out; unsigned char* ws; int ph_lo, ph_hi, li, pad; };
__global__ void __launch_bounds__(NWAVES * 64, 2) fwd(Args args) {
    extern __shared__ __attribute__((aligned(16))) unsigned char lds_raw[];
    LAS unsigned char* lds = (LAS unsigned char*)lds_raw;
    const int tid = threadIdx.x, lane = tid & 63, wave = __builtin_amdgcn_readfirstlane(tid >> 6);
    const int G = gridDim.x, bx = blockIdx.x;
    const int vcu = (G % 8 == 0) ? (bx % 8) * (G / 8) + bx / 8 : bx;
    volatile LAS unsigned* MISC = (volatile LAS unsigned*)(lds + MISC_OFF);
    LAS float* wsc = (LAS float*)(lds + WSC_OFF);
    unsigned char* ws = args.ws;
    unsigned* ctl = (unsigned*)(ws + WS_CTL);
    for (int u = tid; u < (LDS_BYTES - MISC_OFF) / 4; u += NWAVES * 64) ((LAS unsigned*)(lds + MISC_OFF))[u] = 0u;
    __syncthreads();
    XcdBarrier bar; bar.bar = ctl + CW_BAR; bar.x = 0; bar.st = nullptr;
    if (!MK_PER_PHASE) bar = xcd_barrier_post(ctl + CW_BAR, MISC + 8);
    const int lo = args.ph_lo, hi_ph = args.ph_hi;
#ifndef PH_MASK
#define PH_MASK 0x3ff
#endif
#define IN(k) (((PH_MASK >> (k)) & 1) && lo <= (k) && (k) < hi_ph)
#define REP(k) for (int rep_ = 0; rep_ < ((REPEAT_PHASE == (k)) ? 2 : 1); ++rep_)
#define SEAM(k) do { if (IN(k) && IN((k) + 1)) xcd_barrier(bar); } while (0)
    const float* x = args.in[0]; const float* mem = args.in[1];
    bf16_t* win0t = (bf16_t*)(ws + WS_WIN0T); bf16_t* poolwt = (bf16_t*)(ws + WS_POOLWT); bf16_t* wkv0t = (bf16_t*)(ws + WS_WKV0T); bf16_t* wout0t = (bf16_t*)(ws + WS_WOUT0T);
    bf16_t* win1t = (bf16_t*)(ws + WS_WIN1T); bf16_t* wkv1t = (bf16_t*)(ws + WS_WKV1T); bf16_t* wout1t = (bf16_t*)(ws + WS_WOUT1T);
    bf16_t* hbuf = (bf16_t*)(ws + WS_H); bf16_t* mn0 = (bf16_t*)(ws + WS_MN0); bf16_t* mn1 = (bf16_t*)(ws + WS_MN1); bf16_t* kv0 = (bf16_t*)(ws + WS_KV0); bf16_t* kv1 = (bf16_t*)(ws + WS_KV1);
    bf16_t* ubuf = (bf16_t*)(ws + WS_U); bf16_t* plbuf = (bf16_t*)(ws + WS_PL); bf16_t* vbuf = (bf16_t*)(ws + WS_V); bf16_t* qmbuf = (bf16_t*)(ws + WS_QM); bf16_t* szbuf = (bf16_t*)(ws + WS_SZ);
    bf16_t* x2b = (bf16_t*)(ws + WS_X1); bf16_t* ygbuf = (bf16_t*)(ws + WS_YG);
    float* rowss1 = (float*)(ws + WS_CTL) + CW_ROWSS; float* rowss2 = rowss1 + M;
    const int gw = vcu * NWAVES + wave, NGW = G * NWAVES;

    if (IN(0)) REP(0) {
        LAS float* scr = (LAS float*)(lds + wave * 16384);
        constexpr int I_IN0 = (DM / 64) * (N0 / 32), I_PW = (PGRP / 64) * (PGRP / 32), I_KV = (DM / 64) * (DM / 32), I_OUT = (DI / 64) * (DM / 32), I_IN1 = (DM / 64) * (N1 / 32);
        for (int it = gw; it < 2 * I_KV; it += NGW) {
            if (it < I_KV) transpose_item(args.in[7], DM, DM, wkv0t, LD4, scr, it, lane); else transpose_item(args.in[17], DM, DM, wkv1t, LD4, scr, it - I_KV, lane); }
        for (int m = gw; m < MROWS; m += NGW) rms_row_bf16(mem + (size_t)m * DM, args.in[6], mn0 + (size_t)m * LD4, args.in[16], mn1 + (size_t)m * LD4, lane);
        if (!MK_PER_PHASE) xcd_barrier(bar);
        const int gh = G / 2;
        if (bx < gh) {
            pg8::Gemm g{mn0, wkv0t, LD4, LD4, DM, (size_t)(WS_MN1 - WS_MN0), (size_t)(WS_WKV1T - WS_WKV0T)}; pg8::Sched S; S.init(MROWS / 256, DM / 256, 2, gh, bx);
            pg8::EpiKV E{kv0, kv1};
            pg8::gemm_phase<pg8::EpiKV>(lds, g, S, E);
        } else {
            const int gw2 = (bx - gh) * NWAVES + wave, ngw2 = (G - gh) * NWAVES;
            for (int m = gw2; m < M; m += 2 * ngw2) {
                if (m + ngw2 < M) rms_row2_bf16(x + (size_t)m * DM, x + (size_t)(m + ngw2) * DM, args.in[2], hbuf + (size_t)m * LD4, hbuf + (size_t)(m + ngw2) * LD4, lane);
                else rms_row_bf16(x + (size_t)m * DM, args.in[2], hbuf + (size_t)m * LD4, nullptr, nullptr, lane); }
        }
        { constexpr int NQ = I_IN0 + 4 * I_PW + 2 * I_OUT + I_IN1, QSH = NQ / 8, QCH = 2; static_assert(NQ % 8 == 0 && QSH % QCH == 0, "queue shards");
          unsigned* qhead = ctl + CW_QUEUE;
#define Q_PULL(sh_) ({ unsigned v_ = 0u; if (lane == 0) v_ = __hip_atomic_fetch_add(qhead + 64 * (sh_), (unsigned)QCH, __ATOMIC_RELAXED, __HIP_MEMORY_SCOPE_AGENT); v_; })
#define TR_DECODE(d_, it_) do { int r = (it_);                                                                                                  \
            if (r < I_IN0) { tr_set(d_, args.in[3], N0, win0t, LD4, r, nullptr, DM / 256); break; } r -= I_IN0;                                                    \
            if (r < 4 * I_PW) { const int g = r / I_PW; tr_set(d_, args.in[4] + (size_t)g * PGRP * PGRP, PGRP, poolwt + (size_t)g * PGRP * LDP, LDP, r % I_PW, nullptr); break; } r -= 4 * I_PW; \
            if (r < I_OUT) { tr_set(d_, args.in[8], DM, wout0t, LD8, r, nullptr, DI / 256); break; } r -= I_OUT;                                                   \
            if (r < I_IN1) { tr_set(d_, args.in[10], N1, win1t, LD4, r, args.in[9], DM / 256); break; } r -= I_IN1;                                                \
            tr_set(d_, args.in[18], DM, wout1t, LD8, r, nullptr, DI / 256); } while (0)
          int shard = bx & 7, tried = 0; unsigned nxt_v = Q_PULL(shard);
          for (;;) {
              const unsigned cur = (unsigned)__builtin_amdgcn_readfirstlane((int)nxt_v);
              if (cur >= (unsigned)QSH) { if (++tried == 8) break; shard = (shard + 1) & 7; nxt_v = Q_PULL(shard); continue; }
              TrDesc d, e; float wv[32], wu[32]; const int base = shard * QSH + (int)cur;
              TR_DECODE(d, base); tr_load(d, wv, lane); TR_DECODE(e, base + 1); tr_load(e, wu, lane);
              nxt_v = Q_PULL(shard);
              tr_finish(d, wv, scr, lane); tr_finish(e, wu, scr, lane);
          }
#undef TR_DECODE
#undef Q_PULL
        }
    }
    SEAM(0);
    if (IN(1)) REP(1) {
        pg8::Gemm g{hbuf, win0t, LD4, 256, DM, 0, 0, 0, 1}; pg8::Sched S; S.init(M / 256, N0 / 256, 1, G, bx); S.pnon = 32;
        pg8::EpiProj E{ubuf, ubuf, ubuf, qmbuf, szbuf, 24, 24, 24, 32, nullptr};
        pg8::gemm_phase<pg8::EpiProj>(lds, g, S, E);
    }
    SEAM(1);
    if (IN(2)) REP(2) { pool_items(ubuf, plbuf, gw, NGW, lane); }
    SEAM(2);
    if (IN(3)) REP(3) {
        { pg8::Gemm g{plbuf, poolwt, LD6, LDP, PGRP, (size_t)PGRP * 2, (size_t)PGRP * LDP * 2}; pg8::Sched S; S.init(M / 256, PGRP / 256, 4, G, bx);
          pg8::EpiPool E{szbuf, ygbuf, args.in[5]};
          pg8::gemm_phase<pg8::EpiPool>(lds, g, S, E); }
        { const att::MemArgs MA{qmbuf, kv0, szbuf, ygbuf};
          for (int u = bx; u < 256; u += G) att::mem_unit(lds, wsc, MA, u >> 6, (u >> 4) & 3, (u >> 1) & 7, u & 1, wave, lane); }
    }
    SEAM(3);
    if (IN(4)) REP(4) {
        pg8::Gemm g{ygbuf, wout0t, 256, 256, DI, 0, 0, 1, 1}; pg8::Sched S; S.init(M / 256, DM / 256, 1, G, bx);
        pg8::EpiResid<false> E{x, hbuf, rowss1};
        pg8::gemm_phase<pg8::EpiResid<false>>(lds, g, S, E);
    }
    SEAM(4);
    if (IN(6)) REP(6) {
        pg8::Gemm g{hbuf, win1t, LD4, 256, DM, 0, 0, 0, 1}; pg8::Sched S; S.init(M / 256, N1 / 256, 1, G, bx); S.pnon = 80;
        pg8::EpiProj E{ubuf, plbuf, vbuf, qmbuf, szbuf, 24, 48, 72, 80, rowss1};
        pg8::gemm_phase<pg8::EpiProj>(lds, g, S, E);
    }
    SEAM(6);
    if (IN(7)) REP(7) {
        float d1 = args.in[11][lane] * args.in[12][lane] + args.in[11][lane + 64] * args.in[12][lane + 64];
        float d2 = args.in[13][lane] * args.in[14][lane] + args.in[13][lane + 64] * args.in[14][lane + 64];
        d1 = wave_sum(d1); d2 = wave_sum(d2);
        const float lam_init = 0.8f - 0.6f * 0.7408182206817179f;
        const float lam = __expf(d1) - __expf(d2) + lam_init;
        const att::DiffArgs DA{ubuf, plbuf, vbuf, szbuf, ygbuf, args.in[15], lam, 1.0f - lam_init};
        for (int it = bx; it < 768; it += G) {
            const int c = it & 255, rr = it >> 8, x = c & 7, j = c >> 3, k1 = rr * 4 + (j >> 4) * 2, qbi = j & 15;
            const int bh1 = x * 12 + k1, bh2 = bh1 + 1;
            att::diff_unit(lds, wsc, DA, bh1 / NHEAD, bh1 % NHEAD, qbi, 0, wave, lane);
            att::diff_unit(lds, wsc, DA, bh2 / NHEAD, bh2 % NHEAD, 15 - qbi, 1, wave, lane);
        }
        const att::MemArgs MA{qmbuf, kv1, szbuf, ygbuf};
        for (int u = bx; u < 256; u += G) att::mem_unit(lds, wsc, MA, u >> 6, (u >> 4) & 3, (u >> 1) & 7, u & 1, wave, lane);
    }
    SEAM(7);
    if (IN(8)) REP(8) {
        pg8::Gemm g{ygbuf, wout1t, 256, 256, DI, 0, 0, 1, 1}; pg8::Sched S; S.init(M / 256, DM / 256, 1, G, bx);
        pg8::EpiResid<true> E{hbuf, x2b, rowss2};
        pg8::gemm_phase<pg8::EpiResid<true>>(lds, g, S, E);
    }
    SEAM(8);
    if (IN(9)) REP(9) {
        for (int m = gw; m < M; m += 2 * NGW) {
            if (m + NGW < M) final_row2(x2b + (size_t)m * LD4, x2b + (size_t)(m + NGW) * LD4, rowss2 + m, rowss2 + m + NGW, args.in[19], args.out + (size_t)m * DM, args.out + (size_t)(m + NGW) * DM, lane);
            else final_row(x2b + (size_t)m * LD4, rowss2 + m, args.in[19], args.out + (size_t)m * DM, lane);
        }
    }
#undef IN
#undef SEAM
}

extern "C" void kernel_launch(void* const* d_in, const int* in_sizes, int n_in, void* d_out, int out_size, void* d_ws, size_t ws_size, hipStream_t stream) {
    static int grid = 0;
    if (grid == 0) {
        if (n_in != 20 || out_size != M * DM || ws_size < WS_END) { fprintf(stderr, "kernel_launch: unexpected shapes (n_in %d out %d ws %zu)\n", n_in, out_size, ws_size); grid = -1; return; }
        int dev = 0, cus = 0, per_cu = 0;
        if (hipGetDevice(&dev) != hipSuccess || hipDeviceGetAttribute(&cus, hipDeviceAttributeMultiprocessorCount, dev) != hipSuccess) { grid = -1; return; }
        if (hipFuncSetAttribute((const void*)fwd, hipFuncAttributeMaxDynamicSharedMemorySize, LDS_BYTES) != hipSuccess) { fprintf(stderr, "kernel_launch: hipFuncSetAttribute failed\n"); grid = -1; return; }
        if (hipOccupancyMaxActiveBlocksPerMultiprocessor(&per_cu, (const void*)fwd, NWAVES * 64, LDS_BYTES) != hipSuccess || per_cu < 1)
            fprintf(stderr, "kernel_launch: occupancy query reports %d blocks per CU\n", per_cu);
        (void)hipGetLastError();
        grid = cus;
    }
    if (grid < 0) return;
    (void)hipMemsetAsync((char*)d_ws + WS_CTL, 0, CTL_ZERO_BYTES, stream);
    Args a{};
    for (int i = 0; i < 20; ++i) a.in[i] = (const float*)d_in[i];
    a.out = (float*)d_out; a.ws = (unsigned char*)d_ws; a.pad = 0;
#if MK_PER_PHASE
    for (int p = 0; p < NPHASE; ++p) { a.ph_lo = p; a.ph_hi = p + 1; a.li = p; hipLaunchKernelGGL(fwd, dim3(grid), dim3(NWAVES * 64), LDS_BYTES, stream, a); }
#else
    a.ph_lo = 0; a.ph_hi = NPHASE; a.li = 0;
    hipLaunchKernelGGL(fwd, dim3(grid), dim3(NWAVES * 64), LDS_BYTES, stream, a);
#endif
    const hipError_t le = hipPeekAtLastError();
    if (le != hipSuccess) fprintf(stderr, "kernel_launch: launch failed: %s\n", hipGetErrorName(le));
}
```
